# Optimizing an MI355X kernel written in HIP

```python
import math
import jax, jax.numpy as jnp
from jax import lax
import numpy as np

D_MODEL = 2048
BATCH = 4
SEQ = 2048
DEPTH = 1
DEC_BATCH = 128
DEC_SEQ = 8
PAST_LEN = 16384
PAGE_SIZE = 128

SSD_WIDTH = D_MODEL
SSD_HEAD_DIM = 64
SSD_HEADS = SSD_WIDTH // SSD_HEAD_DIM
SSD_GROUPS = 4
SSD_HEADS_PER_GROUP = SSD_HEADS // SSD_GROUPS
SSD_STATE = 128
SSD_CONV = 4
SSD_CONV_DIM = SSD_WIDTH + 2 * SSD_GROUPS * SSD_STATE
SSD_CHUNK = 128
SC_WIDTH = D_MODEL
SC_CONV = 3
MIX_WIDTH = SSD_WIDTH + SC_WIDTH
IN_DIM = SSD_WIDTH + SSD_CONV_DIM + SSD_HEADS + 3 * SC_WIDTH
MEM_TOKENS = 256
MEM_HEADS = 4
MEM_HEAD_DIM = D_MODEL // MEM_HEADS
PEER_HEADS = 8
PEER_NKEYS = 128
PEER_EXPERTS = PEER_NKEYS * PEER_NKEYS
PEER_QDIM = 256
PEER_HALF = PEER_QDIM // 2
PEER_TOPK = 16
PEER_BLOCK = 64
EPS = 1e-6

kernel_name = 'hymba_ssd_shortconv_peer_memxattn_step'


def rmsnorm(x, g):
    xf = x.astype(jnp.float32)
    y = xf * lax.rsqrt(jnp.mean(xf * xf, axis=-1, keepdims=True) + EPS)
    return (y * g.astype(jnp.float32)).astype(x.dtype)


def causal_dwconv(x, buf, w, b=None):
    k = w.shape[0]
    n = x.shape[1]
    xp = jnp.concatenate([buf.astype(x.dtype), x], axis=1)
    y = xp[:, 0:n] * w[0]
    for j in range(1, k):
        y = y + xp[:, j:j + n] * w[j]
    if b is not None:
        y = y + b
    return y, xp[:, n:]


def ssd_scan(x, dt, a_log, bm, cm, d_skip, init_state):
    f32 = jnp.float32
    G, R, P, N = SSD_GROUPS, SSD_HEADS_PER_GROUP, SSD_HEAD_DIM, SSD_STATE
    b, L = x.shape[0], x.shape[1]
    cs = min(SSD_CHUNK, L)
    nc = -(-L // cs)
    pad = nc * cs - L
    xf, dtf, bf, cf = x.astype(f32), dt.astype(f32), bm.astype(f32), cm.astype(f32)
    if pad:
        padt = lambda t: jnp.pad(t, [(0, 0), (0, pad)] + [(0, 0)] * (t.ndim - 2))
        xf, dtf, bf, cf = padt(xf), padt(dtf), padt(bf), padt(cf)
    A = -jnp.exp(a_log.astype(f32)).reshape(G, R)
    a = (dtf * A).reshape(b, nc, cs, G, R)
    xdt = (xf * dtf[..., None]).reshape(b, nc, cs, G, R, P)
    bc = bf.reshape(b, nc, cs, G, N)
    cc = cf.reshape(b, nc, cs, G, N)
    a_cs = jnp.cumsum(jnp.transpose(a, (0, 3, 4, 1, 2)), axis=-1)
    tril = jnp.tril(jnp.ones((cs, cs), dtype=bool))
    lmat = jnp.exp(jnp.where(tril, a_cs[..., :, None] - a_cs[..., None, :], -jnp.inf))
    cb = jnp.einsum('bclgn,bcsgn->bgcls', cc, bc)
    y_diag = jnp.einsum('bgcls,bgrcls,bcsgrp->bclgrp', cb, lmat, xdt)
    decay_states = jnp.exp(a_cs[..., -1:] - a_cs)
    states = jnp.einsum('bcsgn,bgrcs,bcsgrp->bcgrpn', bc, decay_states, xdt)
    states = jnp.concatenate([init_state.astype(f32)[:, None], states], axis=1)
    tot = jnp.cumsum(jnp.pad(a_cs[..., -1], [(0, 0), (0, 0), (0, 0), (1, 0)]), axis=-1)
    tril2 = jnp.tril(jnp.ones((nc + 1, nc + 1), dtype=bool))
    decay_chunk = jnp.exp(jnp.where(tril2, tot[..., :, None] - tot[..., None, :], -jnp.inf))
    new_states = jnp.einsum('bgrzc,bcgrpn->bzgrpn', decay_chunk, states)
    y_off = jnp.einsum('bclgn,bcgrpn,bgrcl->bclgrp', cc, new_states[:, :-1], jnp.exp(a_cs))
    y = (y_diag + y_off).reshape(b, nc * cs, G, R, P)[:, :L]
    y = y + d_skip.astype(f32).reshape(G, R)[:, :, None] * x.astype(f32)
    return y, new_states[:, -1]


def mixer(xn, ssm_state, ssd_buf, sc_buf, w_in, conv_w, conv_b, dt_bias, a_log, d_skip, ssd_norm, sc_w, w_out):
    f32 = jnp.float32
    b, L, _ = xn.shape
    G, R, P, N = SSD_GROUPS, SSD_HEADS_PER_GROUP, SSD_HEAD_DIM, SSD_STATE
    s1 = SSD_WIDTH
    s2 = s1 + SSD_CONV_DIM
    s3 = s2 + SSD_HEADS
    s4 = s3 + SC_WIDTH
    s5 = s4 + SC_WIDTH
    h = xn @ w_in
    z, xbc, dt, sc_h, sc_b, sc_c = jnp.split(h, [s1, s2, s3, s4, s5], axis=-1)
    xbc, new_ssd_buf = causal_dwconv(xbc, ssd_buf, conv_w, conv_b)
    xbc = jax.nn.silu(xbc)
    xs, bm, cm = jnp.split(xbc, [SSD_WIDTH, SSD_WIDTH + G * N], axis=-1)
    dt = jax.nn.softplus(dt.astype(f32) + dt_bias.astype(f32))
    y, new_state = ssd_scan(xs.reshape(b, L, G, R, P), dt.reshape(b, L, G, R), a_log,
                            bm.reshape(b, L, G, N), cm.reshape(b, L, G, N), d_skip,
                            ssm_state.reshape(b, G, R, P, N))
    yg = (y.reshape(b, L, SSD_WIDTH) * jax.nn.silu(z.astype(f32))).reshape(b, L, G, SSD_WIDTH // G)
    yg = yg * lax.rsqrt(jnp.mean(yg * yg, axis=-1, keepdims=True) + EPS)
    y_ssd = (yg.reshape(b, L, SSD_WIDTH) * ssd_norm.astype(f32)).astype(xn.dtype)
    cv, new_sc_buf = causal_dwconv(sc_c * sc_h, sc_buf, sc_w)
    y_sc = sc_b * cv
    out = jnp.concatenate([y_ssd, y_sc], axis=-1) @ w_out
    return out, new_state.reshape(b, SSD_HEADS, P, N), new_ssd_buf, new_sc_buf


def mem_kv(mem, g, wk, wv):
    b = mem.shape[0]
    mn = rmsnorm(mem, g)
    k = (mn @ wk).reshape(b, MEM_TOKENS, MEM_HEADS, MEM_HEAD_DIM)
    v = (mn @ wv).reshape(b, MEM_TOKENS, MEM_HEADS, MEM_HEAD_DIM)
    return k, v


def mem_attend(xn, k, v, wq, wo):
    b, L, _ = xn.shape
    q = (xn @ wq).reshape(b, L, MEM_HEADS, MEM_HEAD_DIM)
    s = jnp.einsum('blhd,bmhd->bhlm', q, k.astype(q.dtype)).astype(jnp.float32) * (1.0 / math.sqrt(MEM_HEAD_DIM))
    p = jax.nn.softmax(s, axis=-1)
    o = jnp.einsum('bhlm,bmhd->blhd', p.astype(v.dtype), v).reshape(b, L, D_MODEL)
    return (o @ wo).astype(xn.dtype)


def peer(xn, wq, sub_keys, u, v):
    f32 = jnp.float32
    b, L, D = xn.shape
    T = b * L
    K = PEER_TOPK
    xt = xn.reshape(T, D)
    q = (xt @ wq).reshape(T, PEER_HEADS, 2, PEER_HALF)
    s = jnp.einsum('thid,hikd->thik', q, sub_keys).astype(f32)
    s1, i1 = lax.top_k(s[:, :, 0], K)
    s2, i2 = lax.top_k(s[:, :, 1], K)
    comb = (s1[..., :, None] + s2[..., None, :]).reshape(T, PEER_HEADS, K * K)
    cid = (i1[..., :, None] * PEER_NKEYS + i2[..., None, :]).reshape(T, PEER_HEADS, K * K)
    sf, pos = lax.top_k(comb, K)
    eid = jnp.take_along_axis(cid, pos, axis=-1).reshape(T, PEER_HEADS * K)
    g = jax.nn.softmax(sf, axis=-1).reshape(T, PEER_HEADS * K)
    nb = -(-T // PEER_BLOCK)
    pad = nb * PEER_BLOCK - T
    xb = jnp.pad(xt, ((0, pad), (0, 0))).reshape(nb, PEER_BLOCK, D)
    eb = jnp.pad(eid, ((0, pad), (0, 0))).reshape(nb, PEER_BLOCK, PEER_HEADS * K)
    gb = jnp.pad(g, ((0, pad), (0, 0))).reshape(nb, PEER_BLOCK, PEER_HEADS * K)

    def block(args):
        xi, ei, gi = args
        act = jax.nn.gelu(jnp.einsum('td,tkd->tk', xi, u[ei]).astype(f32), approximate=False)
        return jnp.einsum('tk,tkd->td', (gi * act).astype(v.dtype), v[ei]).astype(xi.dtype)

    out = lax.map(block, (xb, eb, gb)).reshape(nb * PEER_BLOCK, D)[:T]
    return out.reshape(b, L, D)


def layer(x, mem_k, mem_v, ssm_state, ssd_buf, sc_buf, mix_p, mem_p, ffn_p):
    norm_mix, w_in, conv_w, conv_b, dt_bias, a_log, d_skip, ssd_norm, sc_w, w_out = mix_p
    norm_mem_q, w_mem_q, w_mem_o = mem_p
    norm_ffn, w_peer_q, sub_keys, peer_u, peer_v = ffn_p
    m, new_ssm, new_ssd_buf, new_sc_buf = mixer(rmsnorm(x, norm_mix), ssm_state, ssd_buf, sc_buf, w_in, conv_w,
                                                conv_b, dt_bias, a_log, d_skip, ssd_norm, sc_w, w_out)
    x = x + m
    x = x + mem_attend(rmsnorm(x, norm_mem_q), mem_k, mem_v, w_mem_q, w_mem_o)
    x = x + peer(rmsnorm(x, norm_ffn), w_peer_q, sub_keys, peer_u, peer_v)
    return x, new_ssm, new_ssd_buf, new_sc_buf


def setup_inputs(seed: int = 0) -> dict:
    key = jax.random.key(seed)
    ks = jax.random.split(key, 32)
    f32 = jnp.float32
    nrm = lambda k, shape, s: jax.random.normal(k, shape, f32) * s
    gain = lambda k, shape: 1.0 + 0.02 * jax.random.normal(k, shape, f32)
    dt0 = jnp.exp(jax.random.uniform(ks[13], (DEPTH, SSD_HEADS), f32, math.log(1e-3), math.log(1e-1)))
    return {
        'x_prompt': nrm(ks[0], (BATCH, SEQ, D_MODEL), 1.0),
        'x_sample': nrm(ks[1], (DEC_BATCH, DEC_SEQ, D_MODEL), 1.0),
        'mem_prompt': nrm(ks[2], (BATCH, MEM_TOKENS, D_MODEL), 1.0),
        'state_ssm': nrm(ks[3], (DEPTH, DEC_BATCH, SSD_HEADS, SSD_HEAD_DIM, SSD_STATE), 0.5),
        'state_ssd_conv': nrm(ks[4], (DEPTH, DEC_BATCH, SSD_CONV - 1, SSD_CONV_DIM), 1.0),
        'state_short_conv': nrm(ks[5], (DEPTH, DEC_BATCH, SC_CONV - 1, SC_WIDTH), 1.0),
        'cache_mem_k': nrm(ks[6], (DEPTH, DEC_BATCH, MEM_TOKENS, MEM_HEADS, MEM_HEAD_DIM), 1.0),
        'cache_mem_v': nrm(ks[7], (DEPTH, DEC_BATCH, MEM_TOKENS, MEM_HEADS, MEM_HEAD_DIM), 1.0),
        'norm_mix': gain(ks[8], (DEPTH, D_MODEL)),
        'w_in': nrm(ks[9], (DEPTH, D_MODEL, IN_DIM), D_MODEL ** -0.5),
        'ssd_conv_w': nrm(ks[10], (DEPTH, SSD_CONV, SSD_CONV_DIM), SSD_CONV ** -0.5),
        'ssd_conv_b': nrm(ks[11], (DEPTH, SSD_CONV_DIM), 0.02),
        'ssd_dt_bias': dt0 + jnp.log(-jnp.expm1(-dt0)),
        'ssd_a_log': jnp.log(jax.random.uniform(ks[12], (DEPTH, SSD_HEADS), f32, 1.0, 16.0)),
        'ssd_d': 1.0 + nrm(ks[14], (DEPTH, SSD_HEADS), 0.1),
        'ssd_norm': gain(ks[15], (DEPTH, SSD_WIDTH)),
        'sc_conv_w': nrm(ks[16], (DEPTH, SC_CONV, SC_WIDTH), SC_CONV ** -0.5),
        'w_out': nrm(ks[17], (DEPTH, MIX_WIDTH, D_MODEL), MIX_WIDTH ** -0.5),
        'norm_mem_q': gain(ks[18], (DEPTH, D_MODEL)),
        'norm_mem_kv': gain(ks[19], (DEPTH, D_MODEL)),
        'w_mem_q': nrm(ks[20], (DEPTH, D_MODEL, D_MODEL), D_MODEL ** -0.5),
        'w_mem_k': nrm(ks[21], (DEPTH, D_MODEL, D_MODEL), D_MODEL ** -0.5),
        'w_mem_v': nrm(ks[22], (DEPTH, D_MODEL, D_MODEL), D_MODEL ** -0.5),
        'w_mem_o': nrm(ks[23], (DEPTH, D_MODEL, D_MODEL), D_MODEL ** -0.5),
        'norm_ffn': gain(ks[24], (DEPTH, D_MODEL)),
        'w_peer_q': nrm(ks[25], (DEPTH, D_MODEL, PEER_HEADS * PEER_QDIM), D_MODEL ** -0.5),
        'peer_sub_keys': nrm(ks[26], (DEPTH, PEER_HEADS, 2, PEER_NKEYS, PEER_HALF), PEER_HALF ** -0.5),
        'peer_u': nrm(ks[27], (DEPTH, PEER_EXPERTS, D_MODEL), D_MODEL ** -0.5),
        'peer_v': nrm(ks[28], (DEPTH, PEER_EXPERTS, D_MODEL), 0.1),
        'norm_final': gain(ks[29], (D_MODEL,)),
    }


def reference(x_prompt, x_sample, mem_prompt, state_ssm, state_ssd_conv, state_short_conv, cache_mem_k,
              cache_mem_v, norm_mix, w_in, ssd_conv_w, ssd_conv_b, ssd_dt_bias, ssd_a_log, ssd_d, ssd_norm,
              sc_conv_w, w_out, norm_mem_q, norm_mem_kv, w_mem_q, w_mem_k, w_mem_v, w_mem_o, norm_ffn,
              w_peer_q, peer_sub_keys, peer_u, peer_v, norm_final):
    bp = x_prompt.shape[0]
    hp, hs = x_prompt, x_sample
    p_ssm, p_ssd_conv, p_sc, p_mk, p_mv = [], [], [], [], []
    s_ssm, s_ssd_conv, s_sc = [], [], []
    for i in range(DEPTH):
        mix_p = (norm_mix[i], w_in[i], ssd_conv_w[i], ssd_conv_b[i], ssd_dt_bias[i], ssd_a_log[i], ssd_d[i],
                 ssd_norm[i], sc_conv_w[i], w_out[i])
        mem_p = (norm_mem_q[i], w_mem_q[i], w_mem_o[i])
        ffn_p = (norm_ffn[i], w_peer_q[i], peer_sub_keys[i], peer_u[i], peer_v[i])
        mk, mv = mem_kv(mem_prompt, norm_mem_kv[i], w_mem_k[i], w_mem_v[i])
        z_ssm = jnp.zeros((bp, SSD_HEADS, SSD_HEAD_DIM, SSD_STATE), jnp.float32)
        z_ssd_buf = jnp.zeros((bp, SSD_CONV - 1, SSD_CONV_DIM), x_prompt.dtype)
        z_sc_buf = jnp.zeros((bp, SC_CONV - 1, SC_WIDTH), x_prompt.dtype)
        hp, n_ssm, n_ssd_buf, n_sc_buf = layer(hp, mk, mv, z_ssm, z_ssd_buf, z_sc_buf, mix_p, mem_p, ffn_p)
        p_ssm.append(n_ssm)
        p_ssd_conv.append(n_ssd_buf)
        p_sc.append(n_sc_buf)
        p_mk.append(mk)
        p_mv.append(mv)
        hs, m_ssm, m_ssd_buf, m_sc_buf = layer(hs, cache_mem_k[i], cache_mem_v[i], state_ssm[i],
                                               state_ssd_conv[i], state_short_conv[i], mix_p, mem_p, ffn_p)
        s_ssm.append(m_ssm)
        s_ssd_conv.append(m_ssd_buf)
        s_sc.append(m_sc_buf)
    y_prompt = rmsnorm(hp, norm_final)
    y_sample = rmsnorm(hs, norm_final)
    return (y_prompt, y_sample, jnp.stack(p_ssm), jnp.stack(p_ssd_conv), jnp.stack(p_sc), jnp.stack(p_mk),
            jnp.stack(p_mv), jnp.stack(s_ssm), jnp.stack(s_ssd_conv), jnp.stack(s_sc))
```

```cpp
#include <hip/hip_runtime.h>
#include <cstdio>
#include <cstdint>

#ifndef MK_ONE_LAUNCH
#define MK_ONE_LAUNCH 1
#endif

namespace pg8 {
#define PG8_LAS __attribute__((address_space(3)))
typedef unsigned short bf16_t;
typedef short bf16x8 __attribute__((ext_vector_type(8)));
typedef float f32x4 __attribute__((ext_vector_type(4)));
typedef unsigned u32x4 __attribute__((ext_vector_type(4)));
constexpr int BM = 256, BK = 64, HALF = 128, HTB = HALF * BK * 2  , STAGE_BYTES = 8 * HTB, NXCD = 8, WGM = 8;

__host__ __device__ __forceinline__ int lds_byte(int r, int c) { const int st = (r >> 4) * 2 + (c >> 5), rr = r & 15, cc = c & 31, ob = rr * 64 + cc * 2; return st * 1024 + (ob ^ (((ob >> 9) & 1) << 5)); }
__host__ __device__ __forceinline__ void stage_rc(int b, int& R, int& C) { const int st = b / 1024, sb = b % 1024, swz = sb ^ (((sb >> 9) & 1) << 5); R = (st >> 1) * 16 + swz / 64; C = (st & 1) * 32 + (swz % 64) / 2; }
__host__ __device__ __forceinline__ int perm32(int rho) { const int n = rho >> 4, i = rho & 15; return 8 * (i >> 2) + 4 * n + (i & 3); }

struct Unit { int pm, pn; };
struct Gemm { const bf16_t* A; const bf16_t* Bt; int M, N, K; };

struct StaticOrder {
    int nM, nN, nwg, G, c;
    __host__ __device__ void init(int M, int N, int G_, int c_) { nM = M / BM; nN = N / BM; nwg = nM * nN; G = G_; c = c_; }
    __host__ __device__ bool next(int i, Unit& u) const {
        const long L = (long)i * G + c; if (L >= nwg) return false;
        int wgid = (int)L; { const int q = nwg / NXCD, r = nwg % NXCD, xcd = wgid % NXCD, off = wgid / NXCD; wgid = (xcd < r ? xcd * (q + 1) : r * (q + 1) + (xcd - r) * q) + off; }
        const int nig = WGM * nN, gid = wgid / nig, fm = gid * WGM, gsz = (nM - fm) < WGM ? (nM - fm) : WGM;
        u.pm = fm + ((wgid % nig) % gsz); u.pn = (wgid % nig) / gsz; return true;
    }
    __device__ __forceinline__ void a_ready(const Unit&) const {}
    __device__ __forceinline__ void done(const Unit&) const {}
};

__device__ __forceinline__ unsigned cvt_pk_bf16(float lo, float hi) { unsigned r; asm volatile("v_cvt_pk_bf16_f32 %0, %1, %2" : "=v"(r) : "v"(lo), "v"(hi)); return r; }

struct EpiBf16 {
    static constexpr bool PERM = true, AFTER_DRAIN = false;
    bf16_t* O; int ldc;
    __device__ __forceinline__ void operator()(const f32x4 (&acc)[2][2][4][2], const Unit& u, int wr, int wc, int fr, int fq) const {
        const int row0 = u.pm * BM + wr * 64 + fr; const int col0 = u.pn * BM + wc * 32 + 8 * fq;
#pragma unroll
        for (int ai = 0; ai < 2; ++ai)
#pragma unroll
            for (int m = 0; m < 4; ++m) { bf16_t* rowp = O + (size_t)(row0 + ai * HALF + m * 16) * ldc + col0;
#pragma unroll
                for (int bj = 0; bj < 2; ++bj) { const f32x4 v0 = acc[ai][bj][m][0], v1 = acc[ai][bj][m][1];
                    u32x4 w; w.x = cvt_pk_bf16(v0[0], v0[1]); w.y = cvt_pk_bf16(v0[2], v0[3]); w.z = cvt_pk_bf16(v1[0], v1[1]); w.w = cvt_pk_bf16(v1[2], v1[3]);
                    *(u32x4*)(rowp + bj * HALF) = w; } }
    }
};
struct EpiKV {
    static constexpr bool PERM = true, AFTER_DRAIN = false;
    float* outk; float* outv; bf16_t* kp; bf16_t* vpt;
    __device__ __forceinline__ void operator()(const f32x4 (&acc)[2][2][4][2], const Unit& u, int wr, int wc, int fr, int fq) const {
        const int row0 = u.pm * BM + wr * 64 + fr; const int colt = u.pn * BM; const bool isv = colt >= 2048; const int col0 = (colt & 2047) + wc * 32 + 8 * fq;
        float* of = isv ? outv : outk;
#pragma unroll
        for (int ai = 0; ai < 2; ++ai)
#pragma unroll
            for (int m = 0; m < 4; ++m) { const int row = row0 + ai * HALF + m * 16;
#pragma unroll
                for (int bj = 0; bj < 2; ++bj) { const f32x4 v0 = acc[ai][bj][m][0], v1 = acc[ai][bj][m][1]; const int col = col0 + bj * HALF;
                    float* op = of + (size_t)row * 2048 + col; *(f32x4*)op = v0; *(f32x4*)(op + 4) = v1;
                    u32x4 w; w.x = cvt_pk_bf16(v0[0], v0[1]); w.y = cvt_pk_bf16(v0[2], v0[3]); w.z = cvt_pk_bf16(v1[0], v1[1]); w.w = cvt_pk_bf16(v1[2], v1[3]);
                    if (!isv) { *(u32x4*)(kp + (size_t)row * 2048 + col) = w; }
                    else { const int b = row >> 8, mm = row & 255; bf16_t* tp = vpt + ((size_t)(b * 2048 + col)) * 256 + mm;
                        tp[0 * 256] = (bf16_t)(w.x & 0xffffu); tp[1 * 256] = (bf16_t)(w.x >> 16); tp[2 * 256] = (bf16_t)(w.y & 0xffffu); tp[3 * 256] = (bf16_t)(w.y >> 16);
                        tp[4 * 256] = (bf16_t)(w.z & 0xffffu); tp[5 * 256] = (bf16_t)(w.z >> 16); tp[6 * 256] = (bf16_t)(w.w & 0xffffu); tp[7 * 256] = (bf16_t)(w.w >> 16); } } }
    }
};
template <bool FIRST> struct EpiRes {
    static constexpr bool PERM = false, AFTER_DRAIN = false;
    float* X1; const float* xp; const float* xs;
    __device__ __forceinline__ void operator()(const f32x4 (&acc)[2][2][4][2], const Unit& u, int wr, int wc, int fr, int fq) const {
        const int row0 = u.pm * BM + wr * 64 + fr, col0 = u.pn * BM + wc * 32 + 4 * fq;
#pragma unroll
        for (int ai = 0; ai < 2; ++ai)
#pragma unroll
            for (int m = 0; m < 4; ++m) { const int row = row0 + ai * HALF + m * 16; float* rowp = X1 + (size_t)row * 2048 + col0;
                const float* bp = FIRST ? (row < 8192 ? xp + (size_t)row * 2048 : xs + (size_t)(row - 8192) * 2048) + col0 : rowp;
#pragma unroll
                for (int bj = 0; bj < 2; ++bj)
#pragma unroll
                    for (int n = 0; n < 2; ++n) { const f32x4 b = *(const f32x4*)(bp + bj * HALF + n * 16); *(f32x4*)(rowp + bj * HALF + n * 16) = acc[ai][bj][m][n] + b; } }
    }
};
template <class Epi, class Sched, bool ALIGN_EPI = false, bool SP2 = false>
__device__ __forceinline__ void gemm_phase(PG8_LAS unsigned char* lds, const Gemm g, const Sched& S, const Epi& E) {
    const int tid = threadIdx.x, wid = __builtin_amdgcn_readfirstlane(tid >> 6), lane = tid & 63, wr = wid >> 2, wc = wid & 3, fr = lane & 15, fq = lane >> 4;
    const int K = g.K, nt = K / BK;
    unsigned voffA[2], voffB[2];
#pragma unroll
    for (int i = 0; i < 2; ++i) { int R, C; stage_rc(tid * 16 + i * 8192, R, C); const int Rb = Epi::PERM ? ((R & ~31) + perm32(R & 31)) : R;
        voffA[i] = (unsigned)(R * K + C) * 2u; voffB[i] = (unsigned)(Rb * K + C) * 2u; }
    const size_t kstep = (size_t)(BK * 2);
    const size_t hstep = (size_t)HALF * K * 2;
    const size_t tstep = 2 * hstep;
    const unsigned ldsw = (unsigned)wid * 1024u;
    const int aoff = lds_byte(wr * 64 + fr, fq * 8), boff = lds_byte(wc * 32 + fr, fq * 8);
#define PG8_SA(b, h) (((b) * 2 + (h)) * HTB)
#define PG8_SB(b, h) ((4 + (b) * 2 + (h)) * HTB)
#define PG8_STAGE(bufoff, gbase, voff) do { _Pragma("unroll") for (int _i = 0; _i < 2; ++_i) \
        __builtin_amdgcn_global_load_lds((const unsigned*)((const char*)(gbase) + (voff)[_i]), (PG8_LAS unsigned*)(lds + (bufoff) + ldsw + _i * 8192), 16, 0, 0); } while (0)
#define PG8_LDA(dst, b, h) do { _Pragma("unroll") for (int m = 0; m < 4; ++m) _Pragma("unroll") for (int k = 0; k < 2; ++k) dst[m][k] = *(const PG8_LAS bf16x8*)(lds + PG8_SA(b, h) + aoff + m * 2048 + k * 1024); } while (0)
#define PG8_LDB(dst, b, h) do { _Pragma("unroll") for (int n = 0; n < 2; ++n) _Pragma("unroll") for (int k = 0; k < 2; ++k) dst[n][k] = *(const PG8_LAS bf16x8*)(lds + PG8_SB(b, h) + boff + n * 2048 + k * 1024); } while (0)
#define PG8_MMA(ai, bj, At, Bt) do { __builtin_amdgcn_s_setprio(1); _Pragma("unroll") for (int m = 0; m < 4; ++m) _Pragma("unroll") for (int n = 0; n < 2; ++n) _Pragma("unroll") for (int k = 0; k < 2; ++k) \
        acc[ai][bj][m][n] = __builtin_amdgcn_mfma_f32_16x16x32_bf16(Bt[n][k], At[m][k], acc[ai][bj][m][n], 0, 0, 0); __builtin_amdgcn_s_setprio(0); } while (0)
#define PG8_WAIT_V(n) asm volatile("s_waitcnt vmcnt(" #n ")" ::: "memory")
#define PG8_WAIT_L(n) asm volatile("s_waitcnt lgkmcnt(" #n ")" ::: "memory")
#define PG8_BAR __builtin_amdgcn_s_barrier()
#define PG8_SCHED __builtin_amdgcn_sched_barrier(0)
    Unit cur, nxt; int ui = 0;
    if (!S.next(0, cur)) return;
    f32x4 acc[2][2][4][2];
#pragma unroll
    for (int a = 0; a < 2; ++a)
#pragma unroll
        for (int b = 0; b < 2; ++b)
#pragma unroll
            for (int m = 0; m < 4; ++m)
#pragma unroll
                for (int n = 0; n < 2; ++n) acc[a][b][m][n] = (f32x4){0.f, 0.f, 0.f, 0.f};
    bf16x8 At[4][2], B0[2][2], B1[2][2];
    const char* cA = (const char*)g.A + (size_t)cur.pm * tstep; const char* cB = (const char*)g.Bt + (size_t)cur.pn * tstep;
    S.a_ready(cur);
    if constexpr (SP2) {
        PG8_STAGE(PG8_SB(0, 0), cB, voffB); PG8_STAGE(PG8_SB(0, 1), cB + hstep, voffB); PG8_STAGE(PG8_SA(0, 0), cA, voffA); PG8_STAGE(PG8_SA(0, 1), cA + hstep, voffA);
        if (wr == 1) PG8_BAR;
        PG8_WAIT_V(2); PG8_BAR;
        PG8_STAGE(PG8_SB(1, 0), cB + kstep, voffB); PG8_STAGE(PG8_SA(1, 0), cA + kstep, voffA); PG8_STAGE(PG8_SB(1, 1), cB + hstep + kstep, voffB);
        PG8_WAIT_V(6); PG8_BAR;
    } else {
        PG8_STAGE(PG8_SB(0, 0), cB, voffB); PG8_STAGE(PG8_SA(0, 0), cA, voffA); PG8_STAGE(PG8_SB(0, 1), cB + hstep, voffB); PG8_STAGE(PG8_SA(0, 1), cA + hstep, voffA);
        if (wr == 1) PG8_BAR;
        PG8_WAIT_V(4); PG8_BAR;
        PG8_STAGE(PG8_SB(1, 0), cB + kstep, voffB); PG8_STAGE(PG8_SA(1, 0), cA + kstep, voffA); PG8_STAGE(PG8_SB(1, 1), cB + hstep + kstep, voffB);
        PG8_WAIT_V(6); PG8_BAR;
    }
    for (;;) {
        const bool has_next = S.next(ui + 1, nxt);
        const char* nA = has_next ? (const char*)g.A + (size_t)nxt.pm * tstep : cA; const char* nB = has_next ? (const char*)g.Bt + (size_t)nxt.pn * tstep : cB;
        for (int t = 0; t < nt; t += 2) {
            const bool last = (t == nt - 2);
            const char* a1 = cA + (size_t)(t + 1) * kstep;
            const char* a2 = last ? nA : cA + (size_t)(t + 2) * kstep; const char* b2 = last ? nB : cB + (size_t)(t + 2) * kstep;
            const char* a3 = a2 + kstep; const char* b3 = b2 + kstep;
            if (last && has_next) S.a_ready(nxt);
            if constexpr (SP2) {
            PG8_LDB(B0, 0, 0); PG8_LDB(B1, 0, 1); PG8_SCHED; PG8_LDA(At, 0, 0); PG8_STAGE(PG8_SA(1, 1), a1 + hstep, voffA);
            PG8_WAIT_V(8); PG8_WAIT_L(0); PG8_BAR; PG8_MMA(0, 0, At, B0); PG8_MMA(0, 1, At, B1); PG8_BAR; PG8_SCHED;
            PG8_LDA(At, 0, 1); PG8_STAGE(PG8_SB(0, 0), b2, voffB); PG8_STAGE(PG8_SB(0, 1), b2 + hstep, voffB); PG8_STAGE(PG8_SA(0, 0), a2, voffA);
            PG8_WAIT_V(8); PG8_WAIT_L(0); PG8_BAR; PG8_MMA(1, 0, At, B0); PG8_MMA(1, 1, At, B1); PG8_BAR; PG8_SCHED;
            PG8_LDB(B0, 1, 0); PG8_LDB(B1, 1, 1); PG8_SCHED; PG8_LDA(At, 1, 0); PG8_STAGE(PG8_SA(0, 1), a2 + hstep, voffA);
            PG8_WAIT_V(8); PG8_WAIT_L(0); PG8_BAR; PG8_MMA(0, 0, At, B0); PG8_MMA(0, 1, At, B1); PG8_BAR; PG8_SCHED;
            PG8_LDA(At, 1, 1); PG8_STAGE(PG8_SB(1, 0), b3, voffB); PG8_STAGE(PG8_SB(1, 1), b3 + hstep, voffB); PG8_STAGE(PG8_SA(1, 0), a3, voffA);
            PG8_WAIT_V(8); PG8_WAIT_L(0); PG8_BAR; PG8_MMA(1, 0, At, B0); PG8_MMA(1, 1, At, B1); PG8_BAR; PG8_SCHED;
            } else {
            PG8_LDB(B0, 0, 0); PG8_SCHED; PG8_LDA(At, 0, 0); PG8_STAGE(PG8_SA(1, 1), a1 + hstep, voffA);
            PG8_WAIT_L(8); PG8_BAR; PG8_WAIT_L(0); PG8_MMA(0, 0, At, B0); PG8_BAR; PG8_SCHED;
            PG8_LDB(B1, 0, 1); PG8_STAGE(PG8_SB(0, 0), b2, voffB);
            PG8_BAR; PG8_WAIT_L(0); PG8_MMA(0, 1, At, B1); PG8_BAR;
            PG8_LDA(At, 0, 1); PG8_STAGE(PG8_SA(0, 0), a2, voffA);
            PG8_BAR; PG8_WAIT_L(0); PG8_MMA(1, 0, At, B0); PG8_BAR; PG8_SCHED;
            PG8_STAGE(PG8_SB(0, 1), b2 + hstep, voffB);
            PG8_WAIT_V(6); PG8_BAR; PG8_MMA(1, 1, At, B1); PG8_BAR;
            PG8_LDB(B0, 1, 0); PG8_SCHED; PG8_LDA(At, 1, 0); PG8_STAGE(PG8_SA(0, 1), a2 + hstep, voffA);
            PG8_WAIT_L(8); PG8_BAR; PG8_WAIT_L(0); PG8_MMA(0, 0, At, B0); PG8_BAR; PG8_SCHED;
            PG8_LDB(B1, 1, 1); PG8_STAGE(PG8_SB(1, 0), b3, voffB);
            PG8_BAR; PG8_WAIT_L(0); PG8_MMA(0, 1, At, B1); PG8_BAR;
            PG8_LDA(At, 1, 1); PG8_STAGE(PG8_SA(1, 0), a3, voffA);
            PG8_BAR; PG8_WAIT_L(0); PG8_MMA(1, 0, At, B0); PG8_BAR; PG8_SCHED;
            PG8_STAGE(PG8_SB(1, 1), b3 + hstep, voffB);
            PG8_WAIT_V(6); PG8_BAR; PG8_MMA(1, 1, At, B1); PG8_BAR;
            }
        }
        if constexpr (ALIGN_EPI) { if (wr == 0) PG8_BAR; }
        if constexpr (!Epi::AFTER_DRAIN) { E(acc, cur, wr, wc, fr, fq); S.done(cur); }
        if (!has_next) break;
#pragma unroll
        for (int a = 0; a < 2; ++a)
#pragma unroll
            for (int b = 0; b < 2; ++b)
#pragma unroll
                for (int m = 0; m < 4; ++m)
#pragma unroll
                    for (int n = 0; n < 2; ++n) acc[a][b][m][n] = (f32x4){0.f, 0.f, 0.f, 0.f};
        cur = nxt; cA = nA; cB = nB; ++ui;
        if constexpr (ALIGN_EPI) { if (wr == 1) PG8_BAR; }
    }
    PG8_WAIT_V(0);
    if constexpr (!ALIGN_EPI) { if (wr == 0) PG8_BAR; }
    PG8_BAR;
    if constexpr (Epi::AFTER_DRAIN) { E.fused(acc, cur, wr, wc, fr, fq, lds, wid, lane); S.done(cur); }
#undef PG8_SA
#undef PG8_SB
#undef PG8_STAGE
#undef PG8_LDA
#undef PG8_LDB
#undef PG8_MMA
#undef PG8_WAIT_V
#undef PG8_WAIT_L
#undef PG8_BAR
#undef PG8_SCHED
}
}

constexpr int DM = 2048, NTOK = 9216, TPR = 8192, SEQ = 2048, NBP = 4, NBS = 128, LSM = 8;
constexpr int NIN = 11520;
constexpr int C_Z = 0, C_XBC = 2048, C_DT = 5120, C_SCH = 5376, C_SCB = 7424, C_SCC = 9472;
constexpr int CONVD = 3072;
constexpr int NEXP = 16384;
constexpr float EPS = 1e-6f;
constexpr size_t O_YP = 0, O_YS = 16777216, O_PSSM = 18874368, O_PCONV = 19922944, O_PSC = 19959808, O_PMK = 19976192, O_PMV = 22073344,
                 O_SSSM = 24170496, O_SCONV = 57724928, O_SSC = 58904576, O_END = 59428864;
constexpr size_t al256(size_t x) { return (x + 255) & ~(size_t)255; }
constexpr size_t WS_CTL = 0, CTL_ZERO_BYTES = 1u << 20;
constexpr size_t WS_WIN = CTL_ZERO_BYTES;
constexpr size_t WS_WOUT = WS_WIN + (size_t)NIN * DM * 2;
constexpr size_t WS_WQ = WS_WOUT + (size_t)DM * 4096 * 2;
constexpr size_t WS_WKV = WS_WQ + (size_t)DM * DM * 2;
constexpr size_t WS_WO = WS_WKV + (size_t)4096 * DM * 2;
constexpr size_t WS_WPQ = WS_WO + (size_t)DM * DM * 2;
constexpr size_t WS_SK = WS_WPQ + (size_t)DM * DM * 2;
constexpr size_t WS_U = WS_SK + (size_t)8 * 2 * 128 * 128 * 2;
constexpr size_t WS_V = WS_U + (size_t)NEXP * DM * 2;
constexpr size_t WS_XN = WS_V + (size_t)NEXP * DM * 2;
constexpr size_t WS_MN = WS_XN + (size_t)NTOK * DM * 2;
constexpr size_t WS_H = WS_MN + (size_t)1024 * DM * 2;
constexpr size_t WS_YM = WS_H + (size_t)NTOK * NIN * 2;
constexpr size_t WS_X1 = WS_YM + (size_t)NTOK * 4096 * 2;
constexpr size_t WS_QB = WS_X1 + (size_t)NTOK * DM * 4;
constexpr size_t WS_OB = WS_QB + (size_t)NTOK * DM * 2;
constexpr size_t WS_KP = WS_OB + (size_t)NTOK * DM * 2;
constexpr size_t WS_VPT = WS_KP + (size_t)1024 * DM * 2;
constexpr size_t WS_SLOC = WS_VPT + (size_t)1024 * DM * 2;
constexpr size_t WS_SIN = WS_SLOC + (size_t)4 * 16 * 32 * 64 * 128 * 4;
constexpr size_t WS_DTB = WS_SIN + (size_t)4 * 16 * 32 * 64 * 128 * 2;
constexpr size_t WS_ACS = WS_DTB + (size_t)TPR * 32 * 4;
constexpr size_t WS_EID = WS_ACS + (size_t)TPR * 32 * 4;
constexpr size_t WS_GATE = WS_EID + (size_t)NTOK * 128 * 4;
constexpr size_t WS_END = WS_GATE + (size_t)NTOK * 128 * 4;
constexpr int CW_BAR = 4096;
constexpr int LDS_BYTES = 155648;
constexpr int MISC_OFF = 155648 - 256;
constexpr int NWAVES = 8, NTHR = 512;

#define GAS __attribute__((address_space(1)))
#define LAS __attribute__((address_space(3)))
#define DI __device__ __forceinline__
typedef unsigned short bf16;
typedef unsigned v4u __attribute__((ext_vector_type(4)));
typedef unsigned v2u __attribute__((ext_vector_type(2)));
typedef float f32x4 __attribute__((ext_vector_type(4)));
typedef float f32x2 __attribute__((ext_vector_type(2)));
typedef short bf16x8 __attribute__((ext_vector_type(8)));
typedef __bf16 bf16x2_t __attribute__((ext_vector_type(2)));
#define RLX_AGENT __ATOMIC_RELAXED, __HIP_MEMORY_SCOPE_AGENT
DI unsigned f2bf(float f) { unsigned u = __builtin_bit_cast(unsigned, f); return (u + 0x7fffu + ((u >> 16) & 1u)) >> 16; }
DI unsigned pk2(float lo, float hi) { return f2bf(lo) | (f2bf(hi) << 16); }
DI float bf2f(bf16 v) { return __builtin_bit_cast(float, (unsigned)v << 16); }
DI float bflo(unsigned w) { return __builtin_bit_cast(float, w << 16); }
DI float bfhi(unsigned w) { return __builtin_bit_cast(float, w & 0xffff0000u); }
DI float wave_sum(float v) {
#pragma unroll
    for (int o = 1; o < 64; o <<= 1) v += __shfl_xor(v, o);
    return v;
}
DI float silu_f(float v) { return v / (1.0f + __expf(-v)); }
DI float softplus_f(float x) { return fmaxf(x, 0.f) + log1pf(__expf(-fabsf(x))); }
#define MFMA16(a, b, c) __builtin_amdgcn_mfma_f32_16x16x32_bf16((a), (b), (c), 0, 0, 0)

#define XB_TMO      128
#define XB_XCNT(j)  (256  + 64 * (j))
#define XB_XSUB(j)  (1280 + 64 * (j))
#define XB_XGEN(j)  (2304 + 64 * (j))
#define XB_TOP      3328
#define XB_TOPGEN   3392
#define XCD_BAR_WORDS 3456
#define XB_SPIN_CAP (1u << 18)

__device__ __forceinline__ unsigned xb_ld(unsigned* p)              { return __hip_atomic_load(p, __ATOMIC_RELAXED, __HIP_MEMORY_SCOPE_AGENT); }
__device__ __forceinline__ unsigned xb_add(unsigned* p, unsigned v) { return __hip_atomic_fetch_add(p, v, __ATOMIC_RELAXED, __HIP_MEMORY_SCOPE_AGENT); }
__device__ __forceinline__ unsigned xb_xcc_id() { return (unsigned)__builtin_amdgcn_s_getreg((3 << 11) | 20) & 0xFu; }
#define XB_SPIN(cond, bar) do { unsigned _sp = 0; while (cond) { __builtin_amdgcn_s_sleep(1); \
    if ((++_sp & 255u) == 0u) { if (xb_ld(&(bar)[XB_TMO])) break; if (_sp > XB_SPIN_CAP) { atomicAdd(&(bar)[XB_TMO], 1u); break; } } } } while (0)

struct XcdBarrier {
    unsigned* bar; unsigned x;
    volatile LAS unsigned* st;
};
__device__ __forceinline__ XcdBarrier xcd_barrier_post(unsigned* bar, volatile LAS unsigned* st) {
    XcdBarrier b; b.bar = bar; b.x = xb_xcc_id(); b.st = st;
    if (threadIdx.x == 0) (void)xb_add(&bar[XB_XCNT(b.x)], 1u);
    return b;
}
__device__ __forceinline__ void xcd_barrier_complete(unsigned* bar, unsigned x, unsigned& nloc, unsigned& nx) {
    const unsigned G = gridDim.x * gridDim.y * gridDim.z;
    unsigned sum, cnt, mine, sp = 0u;
    for (;;) {
        sum = 0u; cnt = 0u; mine = 0u;
#pragma unroll
        for (unsigned j = 0; j < 16; ++j) { const unsigned c = xb_ld(&bar[XB_XCNT(j)]); sum += c; cnt += (c > 0u) ? 1u : 0u; mine = (j == x) ? c : mine; }
        if (sum == G) break;
        __builtin_amdgcn_s_sleep(1);
        if ((++sp & 255u) == 0u) { if (xb_ld(&bar[XB_TMO])) break; if (sp > XB_SPIN_CAP) { atomicAdd(&bar[XB_TMO], 1u); break; } }
    }
    nloc = mine > 0u ? mine : 1u; nx = cnt > 0u ? cnt : 1u;
}
__device__ __forceinline__ void xcd_barrier(const XcdBarrier& b) {
    asm volatile("s_waitcnt vmcnt(0)" ::: "memory");
    __syncthreads();
    if (threadIdx.x == 0) {
        unsigned* bar = b.bar;
        __builtin_amdgcn_s_waitcnt(0);
        unsigned nloc = b.st[0], nx = b.st[1];
        if (nloc == 0u) { xcd_barrier_complete(bar, b.x, nloc, nx); b.st[0] = nloc; b.st[1] = nx; }
        const unsigned old = xb_add(&bar[XB_XSUB(b.x)], 1u);
        const unsigned gen = old / nloc;
        if (old + 1u == (gen + 1u) * nloc) {
            __builtin_amdgcn_fence(__ATOMIC_RELEASE, "agent");
            asm volatile("s_waitcnt vmcnt(0)" ::: "memory");
            const unsigned og = xb_add(&bar[XB_TOP], 1u);
            const unsigned tg = og / nx;
            if (og + 1u == (tg + 1u) * nx) xb_add(&bar[XB_TOPGEN], 1u);
            else XB_SPIN(xb_ld(&bar[XB_TOPGEN]) == tg, bar);
            __builtin_amdgcn_fence(__ATOMIC_ACQUIRE, "agent");
            xb_add(&bar[XB_XGEN(b.x)], 1u);
            asm volatile("s_waitcnt vmcnt(0)" ::: "memory");
        } else {
            XB_SPIN(xb_ld(&bar[XB_XGEN(b.x)]) == gen, bar);
            __builtin_amdgcn_fence(__ATOMIC_ACQUIRE, "agent");
            asm volatile("s_waitcnt vmcnt(0)" ::: "memory");
        }
    }
    __syncthreads();
}

struct Args { const float* in[30]; float* out; unsigned char* ws; int ph_lo, ph_hi; };
struct Frame {
    LAS unsigned char* lds;
    int tid, lane, wave;
    int vcu, G;
};
enum { I_XP = 0, I_XS, I_MEM, I_SSM, I_SCONV, I_SSC, I_CK, I_CV, I_NMIX, I_WIN, I_CW, I_CB, I_DTB, I_ALOG, I_D, I_SSDN, I_SCW, I_WOUT, I_NMQ, I_NMKV,
       I_WMQ, I_WMK, I_WMV, I_WMO, I_NFFN, I_WPQ, I_SK, I_U, I_V, I_NF };

DI void p0_transpose_item(const float* W, int N, int K, bf16* WT, int k0, int n0, int dst_row0, LAS float* scr, int lane) {
#pragma unroll 8
    for (int i = 0; i < 32; ++i) { const int kk = 2 * i + (lane >> 5); scr[kk * 33 + (lane & 31)] = W[(size_t)(k0 + kk) * N + n0 + (lane & 31)]; }
    asm volatile("s_waitcnt lgkmcnt(0)" ::: "memory");
    const int c = lane & 7;
#pragma unroll
    for (int j = 0; j < 4; ++j) { const int n = (lane >> 3) + 8 * j; const LAS float* s = scr + (8 * c) * 33 + n;
        v4u o; o.x = pk2(s[0 * 33], s[1 * 33]); o.y = pk2(s[2 * 33], s[3 * 33]); o.z = pk2(s[4 * 33], s[5 * 33]); o.w = pk2(s[6 * 33], s[7 * 33]);
        *(v4u*)(WT + (size_t)(dst_row0 + n) * K + k0 + 8 * c) = o; }
    asm volatile("s_waitcnt lgkmcnt(0)" ::: "memory");
}
DI void rms_row_to_bf16(const float* xrow, const float* gain, bf16* orow, int lane) {
    const f32x4* xr = (const f32x4*)xrow + lane;
    f32x4 v[8]; float s = 0.f;
#pragma unroll
    for (int j = 0; j < 8; ++j) { v[j] = xr[64 * j]; s += (v[j].x * v[j].x + v[j].y * v[j].y) + (v[j].z * v[j].z + v[j].w * v[j].w); }
    const float r = rsqrtf(wave_sum(s) * (1.f / DM) + EPS);
    const f32x4* gr = (const f32x4*)gain + lane;
    v2u* o8 = (v2u*)orow + lane;
#pragma unroll
    for (int j = 0; j < 8; ++j) { const f32x4 g = gr[64 * j]; v2u w; w.x = pk2(v[j].x * r * g.x, v[j].y * r * g.y); w.y = pk2(v[j].z * r * g.z, v[j].w * r * g.w); o8[64 * j] = w; }
}
DI void cvt_f32_bf16_stream(const float* src, bf16* dst, size_t n, size_t gtid, size_t nthr) {
    for (size_t i = gtid * 8; i < n; i += nthr * 8) { const f32x4 a = *(const f32x4*)(src + i), b = *(const f32x4*)(src + i + 4);
        v4u w; w.x = pk2(a.x, a.y); w.y = pk2(a.z, a.w); w.z = pk2(b.x, b.y); w.w = pk2(b.z, b.w); *(v4u*)(dst + i) = w; }
}
DI void phase_prologue(const Frame& F, const Args& A) {
    LAS float* scr = (LAS float*)(F.lds + F.wave * 16384);
    const int gw = F.vcu * NWAVES + F.wave, NGW = F.G * NWAVES;
    unsigned char* ws = A.ws;
    constexpr int NB_IN = 11296 / 32;
    constexpr int I_IN = (DM / 64) * NB_IN, I_OUT = (4096 / 64) * (DM / 32), I_SQ = (DM / 64) * (DM / 32);
    constexpr int NITEMS = I_IN + I_OUT + 5 * I_SQ;
    for (int it = gw; it < NITEMS; it += NGW) {
        int r = it;
        if (r < I_IN) { const int kb = r / NB_IN, nb = r % NB_IN, n0 = 32 * nb; p0_transpose_item(A.in[I_WIN], 11296, DM, (bf16*)(ws + WS_WIN), 64 * kb, n0, n0 < 5152 ? n0 : n0 + 224, scr, F.lane); continue; } r -= I_IN;
        if (r < I_OUT) { const int kb = r / 64, nb = r % 64; p0_transpose_item(A.in[I_WOUT], DM, 4096, (bf16*)(ws + WS_WOUT), 64 * kb, 32 * nb, 32 * nb, scr, F.lane); continue; } r -= I_OUT;
        const int which = r / I_SQ; r -= which * I_SQ; const int kb = r / 64, nb = r % 64;
        const float* W = which == 0 ? A.in[I_WMQ] : which == 1 ? A.in[I_WMK] : which == 2 ? A.in[I_WMV] : which == 3 ? A.in[I_WMO] : A.in[I_WPQ];
        bf16* WT = (bf16*)(ws + (which == 0 ? WS_WQ : which == 1 ? WS_WKV : which == 2 ? WS_WKV + (size_t)DM * DM * 2 : which == 3 ? WS_WO : WS_WPQ));
        p0_transpose_item(W, DM, DM, WT, 64 * kb, 32 * nb, 32 * nb, scr, F.lane);
    }
    const size_t gtid = (size_t)F.vcu * NTHR + F.tid, nthr = (size_t)F.G * NTHR;
    { v4u z = {0u, 0u, 0u, 0u}; v4u* p = (v4u*)(ws + WS_WIN + (size_t)5152 * DM * 2); const size_t n16 = (size_t)224 * DM * 2 / 16; for (size_t i = gtid; i < n16; i += nthr) p[i] = z; }
    cvt_f32_bf16_stream(A.in[I_U], (bf16*)(ws + WS_U), (size_t)NEXP * DM, gtid, nthr);
    cvt_f32_bf16_stream(A.in[I_V], (bf16*)(ws + WS_V), (size_t)NEXP * DM, gtid, nthr);
    cvt_f32_bf16_stream(A.in[I_SK], (bf16*)(ws + WS_SK), (size_t)8 * 2 * 128 * 128, gtid, nthr);
    for (int m = gw; m < NTOK + 1024; m += NGW) {
        if (m < TPR) rms_row_to_bf16(A.in[I_XP] + (size_t)m * DM, A.in[I_NMIX], (bf16*)(ws + WS_XN) + (size_t)m * DM, F.lane);
        else if (m < NTOK) rms_row_to_bf16(A.in[I_XS] + (size_t)(m - TPR) * DM, A.in[I_NMIX], (bf16*)(ws + WS_XN) + (size_t)m * DM, F.lane);
        else rms_row_to_bf16(A.in[I_MEM] + (size_t)(m - NTOK) * DM, A.in[I_NMKV], (bf16*)(ws + WS_MN) + (size_t)(m - NTOK) * DM, F.lane);
    }
}

DI void conv8(const bf16* H, size_t row0, int t, int ch0, const float* cw, const float* cb, const float* hist, float (&o)[8]) {
    { const f32x4 b0 = *(const f32x4*)(cb + ch0), b1 = *(const f32x4*)(cb + ch0 + 4); o[0] = b0.x; o[1] = b0.y; o[2] = b0.z; o[3] = b0.w; o[4] = b1.x; o[5] = b1.y; o[6] = b1.z; o[7] = b1.w; }
#pragma unroll
    for (int j = 0; j < 4; ++j) { const int tt = t - 3 + j;
        const f32x4 w0 = *(const f32x4*)(cw + j * CONVD + ch0), w1 = *(const f32x4*)(cw + j * CONVD + ch0 + 4);
        if (tt >= 0) { const v4u h = *(const v4u*)(H + (row0 + tt) * NIN + C_XBC + ch0);
            o[0] += bflo(h.x) * w0.x; o[1] += bfhi(h.x) * w0.y; o[2] += bflo(h.y) * w0.z; o[3] += bfhi(h.y) * w0.w;
            o[4] += bflo(h.z) * w1.x; o[5] += bfhi(h.z) * w1.y; o[6] += bflo(h.w) * w1.z; o[7] += bfhi(h.w) * w1.w; }
        else if (hist) { const f32x4 h0 = *(const f32x4*)(hist + (3 + tt) * CONVD + ch0), h1 = *(const f32x4*)(hist + (3 + tt) * CONVD + ch0 + 4);
            o[0] += h0.x * w0.x; o[1] += h0.y * w0.y; o[2] += h0.z * w0.z; o[3] += h0.w * w0.w; o[4] += h1.x * w1.x; o[5] += h1.y * w1.y; o[6] += h1.z * w1.z; o[7] += h1.w * w1.w; } }
#pragma unroll
    for (int e = 0; e < 8; ++e) o[e] = silu_f(o[e]);
}
constexpr int LDK = 136;

DI void ssd_pass1_item(const Frame& F, const Args& A, int item) {
    const int g = item & 3, c = (item >> 2) & 15, b = item >> 6;
    const size_t row0 = (size_t)b * SEQ + c * 128, seq0 = (size_t)b * SEQ;
    const bf16* H = (const bf16*)(A.ws + WS_H);
    LAS bf16* BT = (LAS bf16*)(F.lds);
    LAS bf16* XT = (LAS bf16*)(F.lds + 34816);
    LAS float* WSC = (LAS float*)(F.lds + 34816 + 17408);
    float* DTB = (float*)(A.ws + WS_DTB); float* ACS = (float*)(A.ws + WS_ACS);
    const int lane = F.lane, w = F.wave, tid = F.tid, fr = lane & 15, fq = lane >> 4;
    __syncthreads();
    {
        const int h = g * 8 + w; const float Ah = -__expf(A.in[I_ALOG][h]), bias = A.in[I_DTB][h];
        const float dt0 = softplus_f(bf2f(H[(row0 + lane) * NIN + C_DT + h]) + bias), dt1 = softplus_f(bf2f(H[(row0 + lane + 64) * NIN + C_DT + h]) + bias);
        float v0 = dt0 * Ah, v1 = dt1 * Ah;
#pragma unroll
        for (int o = 1; o < 64; o <<= 1) { const float t0 = __shfl_up(v0, o), t1 = __shfl_up(v1, o); if (lane >= o) { v0 += t0; v1 += t1; } }
        v1 += __shfl(v0, 63);
        const float last = __shfl(v1, 63);
        DTB[(row0 + lane) * 32 + h] = dt0; DTB[(row0 + lane + 64) * 32 + h] = dt1;
        ACS[(row0 + lane) * 32 + h] = v0; ACS[(row0 + lane + 64) * 32 + h] = v1;
        WSC[w * 128 + lane] = dt0 * __expf(last - v0); WSC[w * 128 + lane + 64] = dt1 * __expf(last - v1);
    }
#pragma unroll 1
    for (int i = 0; i < 4; ++i) { const int task = tid + 512 * i, s = task >> 4, nc = task & 15; float o[8];
        conv8(H, seq0, c * 128 + s, 2048 + g * 128 + nc * 8, A.in[I_CW], A.in[I_CB], nullptr, o);
#pragma unroll
        for (int e = 0; e < 8; ++e) BT[(nc * 8 + e) * LDK + s] = (bf16)f2bf(o[e]); }
    __syncthreads();
    bf16x8 bfr[4];
#pragma unroll
    for (int ks = 0; ks < 4; ++ks) bfr[ks] = *(const LAS bf16x8*)(BT + (16 * w + fr) * LDK + 32 * ks + 8 * fq);
    float* SLOC = (float*)(A.ws + WS_SLOC);
#pragma unroll 1
    for (int r = 0; r < 8; ++r) {
        const int h = g * 8 + r;
        if (r) __syncthreads();
#pragma unroll 1
        for (int i = 0; i < 2; ++i) { const int task = tid + 512 * i, s = task >> 3, pc = task & 7; float o[8];
            conv8(H, seq0, c * 128 + s, h * 64 + pc * 8, A.in[I_CW], A.in[I_CB], nullptr, o);
            const float sc = WSC[r * 128 + s];
#pragma unroll
            for (int e = 0; e < 8; ++e) XT[(pc * 8 + e) * LDK + s] = (bf16)f2bf(o[e] * sc); }
        __syncthreads();
        f32x4 acc[4];
#pragma unroll
        for (int pb = 0; pb < 4; ++pb) { acc[pb] = (f32x4){0.f, 0.f, 0.f, 0.f};
#pragma unroll
            for (int ks = 0; ks < 4; ++ks) { const bf16x8 a = *(const LAS bf16x8*)(XT + (16 * pb + fr) * LDK + 32 * ks + 8 * fq); acc[pb] = MFMA16(a, bfr[ks], acc[pb]); } }
        float* sl = SLOC + ((((size_t)b * 16 + c) * 32 + h) * 64) * 128;
#pragma unroll
        for (int pb = 0; pb < 4; ++pb)
#pragma unroll
            for (int j = 0; j < 4; ++j) sl[(16 * pb + 4 * fq + j) * 128 + 16 * w + fr] = acc[pb][j];
    }
}

DI void ssd_sample_item(const Frame& F, const Args& A, int item) {
    const int g = item & 3, b = item >> 2;
    const size_t row0 = (size_t)TPR + (size_t)b * LSM;
    const bf16* H = (const bf16*)(A.ws + WS_H);
    LAS float* XS = (LAS float*)(F.lds);
    LAS float* BS = (LAS float*)(F.lds + 16384);
    LAS float* CS = (LAS float*)(F.lds + 20480);
    LAS float* YO = (LAS float*)(F.lds + 24576);
    const int lane = F.lane, w = F.wave, tid = F.tid;
    __syncthreads();
    const float* hist = A.in[I_SCONV] + (size_t)b * 3 * CONVD;
#pragma unroll 1
    for (int task = tid; task < 8 * 96; task += NTHR) { const int t = task / 96, cc = task % 96; float o[8];
        const int ch0 = cc < 64 ? g * 512 + cc * 8 : (cc < 80 ? 2048 + g * 128 + (cc - 64) * 8 : 2560 + g * 128 + (cc - 80) * 8);
        conv8(H, row0, t, ch0, A.in[I_CW], A.in[I_CB], hist, o);
        LAS float* dst = cc < 64 ? XS + t * 512 + cc * 8 : (cc < 80 ? BS + t * 128 + (cc - 64) * 8 : CS + t * 128 + (cc - 80) * 8);
#pragma unroll
        for (int e = 0; e < 8; ++e) dst[e] = o[e]; }
    __syncthreads();
    const int h = g * 8 + w, pl = lane >> 4, nl = lane & 15;
    const float Ah = -__expf(A.in[I_ALOG][h]), bias = A.in[I_DTB][h], Dh = A.in[I_D][h];
    float st[16][8];
    const float* sp = A.in[I_SSM] + (((size_t)b * 32 + h) * 64 + 16 * pl) * 128 + 8 * nl;
#pragma unroll
    for (int i = 0; i < 16; ++i) { const f32x4 a0 = *(const f32x4*)(sp + i * 128), a1 = *(const f32x4*)(sp + i * 128 + 4);
        st[i][0] = a0.x; st[i][1] = a0.y; st[i][2] = a0.z; st[i][3] = a0.w; st[i][4] = a1.x; st[i][5] = a1.y; st[i][6] = a1.z; st[i][7] = a1.w; }
#pragma unroll 1
    for (int t = 0; t < 8; ++t) {
        const float dt = softplus_f(bf2f(H[(row0 + t) * NIN + C_DT + h]) + bias), da = __expf(dt * Ah);
        float bv[8], cv[8];
#pragma unroll
        for (int k = 0; k < 8; ++k) { bv[k] = BS[t * 128 + 8 * nl + k]; cv[k] = CS[t * 128 + 8 * nl + k]; }
        float mine = 0.f;
#pragma unroll
        for (int i = 0; i < 16; ++i) { const float xd = dt * XS[t * 512 + w * 64 + 16 * pl + i]; float yp = 0.f;
#pragma unroll
            for (int k = 0; k < 8; ++k) { st[i][k] = st[i][k] * da + xd * bv[k]; yp += st[i][k] * cv[k]; }
            yp += __shfl_xor(yp, 1); yp += __shfl_xor(yp, 2); yp += __shfl_xor(yp, 4); yp += __shfl_xor(yp, 8);
            mine = (nl == i) ? yp : mine; }
        const int p = 16 * pl + nl;
        const float xv = XS[t * 512 + w * 64 + p], z = bf2f(H[(row0 + t) * NIN + C_Z + h * 64 + p]);
        YO[t * 512 + w * 64 + p] = (mine + Dh * xv) * silu_f(z);
    }
    float* so = A.out + O_SSSM + (((size_t)b * 32 + h) * 64 + 16 * pl) * 128 + 8 * nl;
#pragma unroll
    for (int i = 0; i < 16; ++i) { *(f32x4*)(so + i * 128) = (f32x4){st[i][0], st[i][1], st[i][2], st[i][3]}; *(f32x4*)(so + i * 128 + 4) = (f32x4){st[i][4], st[i][5], st[i][6], st[i][7]}; }
    __syncthreads();
    {
        float v[8]; float ss = 0.f;
#pragma unroll
        for (int k = 0; k < 8; ++k) { v[k] = YO[w * 512 + lane + 64 * k]; ss += v[k] * v[k]; }
        const float r = rsqrtf(wave_sum(ss) * (1.f / 512.f) + EPS);
        bf16* ym = (bf16*)(A.ws + WS_YM) + (row0 + w) * 4096 + g * 512;
#pragma unroll
        for (int k = 0; k < 8; ++k) ym[lane + 64 * k] = (bf16)f2bf(v[k] * r * A.in[I_SSDN][g * 512 + lane + 64 * k]);
    }
}

DI void short_conv_all(const Frame& F, const Args& A) {
    const bf16* H = (const bf16*)(A.ws + WS_H); bf16* YM = (bf16*)(A.ws + WS_YM);
    const float* scw = A.in[I_SCW];
    const size_t gtid = (size_t)F.vcu * NTHR + F.tid, nthr = (size_t)F.G * NTHR;
    for (size_t task = gtid; task < (size_t)NTOK * 256; task += nthr) {
        const int row = (int)(task >> 8), ch0 = (int)(task & 255) * 8;
        const bool pr = row < TPR; const int b = pr ? row >> 11 : (row - TPR) >> 3, t = pr ? row & 2047 : (row - TPR) & 7, L = pr ? SEQ : LSM;
        float cv[8], ucur[8];
#pragma unroll
        for (int e = 0; e < 8; ++e) cv[e] = 0.f;
#pragma unroll
        for (int j = 0; j < 3; ++j) { const int tt = t - 2 + j; float u[8];
            if (tt >= 0) { const v4u hc = *(const v4u*)(H + (size_t)(row - t + tt) * NIN + C_SCC + ch0), hh = *(const v4u*)(H + (size_t)(row - t + tt) * NIN + C_SCH + ch0);
                u[0] = bflo(hc.x) * bflo(hh.x); u[1] = bfhi(hc.x) * bfhi(hh.x); u[2] = bflo(hc.y) * bflo(hh.y); u[3] = bfhi(hc.y) * bfhi(hh.y);
                u[4] = bflo(hc.z) * bflo(hh.z); u[5] = bfhi(hc.z) * bfhi(hh.z); u[6] = bflo(hc.w) * bflo(hh.w); u[7] = bfhi(hc.w) * bfhi(hh.w); }
            else if (!pr) { const float* hp = A.in[I_SSC] + ((size_t)b * 2 + (2 + tt)) * DM + ch0; const f32x4 a0 = *(const f32x4*)hp, a1 = *(const f32x4*)(hp + 4);
                u[0] = a0.x; u[1] = a0.y; u[2] = a0.z; u[3] = a0.w; u[4] = a1.x; u[5] = a1.y; u[6] = a1.z; u[7] = a1.w; }
            else {
#pragma unroll
                for (int e = 0; e < 8; ++e) u[e] = 0.f; }
            const f32x4 w0 = *(const f32x4*)(scw + j * DM + ch0), w1 = *(const f32x4*)(scw + j * DM + ch0 + 4);
            cv[0] += u[0] * w0.x; cv[1] += u[1] * w0.y; cv[2] += u[2] * w0.z; cv[3] += u[3] * w0.w; cv[4] += u[4] * w1.x; cv[5] += u[5] * w1.y; cv[6] += u[6] * w1.z; cv[7] += u[7] * w1.w;
            if (j == 2) {
#pragma unroll
                for (int e = 0; e < 8; ++e) ucur[e] = u[e]; } }
        const v4u hb = *(const v4u*)(H + (size_t)row * NIN + C_SCB + ch0);
        v4u o; o.x = pk2(bflo(hb.x) * cv[0], bfhi(hb.x) * cv[1]); o.y = pk2(bflo(hb.y) * cv[2], bfhi(hb.y) * cv[3]); o.z = pk2(bflo(hb.z) * cv[4], bfhi(hb.z) * cv[5]); o.w = pk2(bflo(hb.w) * cv[6], bfhi(hb.w) * cv[7]);
        *(v4u*)(YM + (size_t)row * 4096 + 2048 + ch0) = o;
        if (t >= L - 2) { float* op = A.out + (pr ? O_PSC : O_SSC) + ((size_t)b * 2 + (t - (L - 2))) * DM + ch0;
            *(f32x4*)op = (f32x4){ucur[0], ucur[1], ucur[2], ucur[3]}; *(f32x4*)(op + 4) = (f32x4){ucur[4], ucur[5], ucur[6], ucur[7]}; }
    }
    for (size_t task = gtid; task < (size_t)(NBP + NBS) * 3 * (CONVD / 8); task += nthr) {
        const int cc = (int)(task % (CONVD / 8)), j = (int)((task / (CONVD / 8)) % 3), bb = (int)(task / (3 * (CONVD / 8)));
        const bool pr = bb < NBP; const int b = pr ? bb : bb - NBP;
        const size_t row = pr ? (size_t)b * SEQ + (SEQ - 3 + j) : (size_t)TPR + (size_t)b * LSM + (LSM - 3 + j);
        const v4u h = *(const v4u*)(H + row * NIN + C_XBC + cc * 8);
        float* op = A.out + (pr ? O_PCONV : O_SCONV) + ((size_t)b * 3 + j) * CONVD + cc * 8;
        *(f32x4*)op = (f32x4){bflo(h.x), bfhi(h.x), bflo(h.y), bfhi(h.y)}; *(f32x4*)(op + 4) = (f32x4){bflo(h.z), bfhi(h.z), bflo(h.w), bfhi(h.w)};
    }
}

DI void ssd_propagate(const Frame& F, const Args& A) {
    const float* SLOC = (const float*)(A.ws + WS_SLOC); bf16* SIN = (bf16*)(A.ws + WS_SIN); const float* ACS = (const float*)(A.ws + WS_ACS);
    const size_t gtid = (size_t)F.vcu * NTHR + F.tid, nthr = (size_t)F.G * NTHR;
    for (size_t idx = gtid; idx < (size_t)4 * 32 * 64 * 32; idx += nthr) {
        const int n4 = (int)(idx & 31), p = (int)((idx >> 5) & 63), h = (int)((idx >> 11) & 31), b = (int)(idx >> 16);
        f32x4 S = {0.f, 0.f, 0.f, 0.f};
#pragma unroll 4
        for (int c = 0; c < 16; ++c) {
            const size_t off = ((((size_t)b * 16 + c) * 32 + h) * 64 + p) * 128 + n4 * 4;
            v2u w; w.x = pk2(S.x, S.y); w.y = pk2(S.z, S.w); *(v2u*)(SIN + off) = w;
            const float dec = __expf(ACS[((size_t)b * SEQ + c * 128 + 127) * 32 + h]);
            const f32x4 l = *(const f32x4*)(SLOC + off);
            S = S * dec + l;
        }
        *(f32x4*)(A.out + O_PSSM + (((size_t)b * 32 + h) * 64 + p) * 128 + n4 * 4) = S;
    }
}

DI void ssd_pass2_item(const Frame& F, const Args& A, int item) {
    const int g = item & 3, c = (item >> 2) & 15, b = item >> 6;
    const size_t row0 = (size_t)b * SEQ + c * 128, seq0 = (size_t)b * SEQ;
    const bf16* H = (const bf16*)(A.ws + WS_H);
    LAS bf16* Bn = (LAS bf16*)(F.lds);
    LAS bf16* Cn = (LAS bf16*)(F.lds + 34816);
    LAS bf16* XT = (LAS bf16*)(F.lds + 69632);
    LAS bf16* XR = (LAS bf16*)(F.lds + 87040);
    LAS bf16* Mw = (LAS bf16*)(F.lds + 104448);
    LAS float* ACSL = (LAS float*)(F.lds + 139264);
    LAS float* DTL = (LAS float*)(F.lds + 143360);
    const int lane = F.lane, w = F.wave, tid = F.tid, fr = lane & 15, fq = lane >> 4;
    __syncthreads();
    { const float* DTB = (const float*)(A.ws + WS_DTB); const float* ACS = (const float*)(A.ws + WS_ACS);
#pragma unroll
      for (int i = 0; i < 2; ++i) { const int e = tid + 512 * i, s = e >> 3, r = e & 7; ACSL[r * 128 + s] = ACS[(row0 + s) * 32 + g * 8 + r]; DTL[r * 128 + s] = DTB[(row0 + s) * 32 + g * 8 + r]; } }
#pragma unroll 1
    for (int i = 0; i < 8; ++i) { const int task = tid + 512 * i, s = task >> 5, cc = task & 31; float o[8];
        const int ch0 = cc < 16 ? 2048 + g * 128 + cc * 8 : 2560 + g * 128 + (cc - 16) * 8;
        conv8(H, seq0, c * 128 + s, ch0, A.in[I_CW], A.in[I_CB], nullptr, o);
        v4u pk; pk.x = pk2(o[0], o[1]); pk.y = pk2(o[2], o[3]); pk.z = pk2(o[4], o[5]); pk.w = pk2(o[6], o[7]);
        *(LAS v4u*)((cc < 16 ? Bn + s * LDK + cc * 8 : Cn + s * LDK + (cc - 16) * 8)) = pk; }
    __syncthreads();
    f32x4 cb[8];
    {   bf16x8 cf[4];
#pragma unroll
        for (int ks = 0; ks < 4; ++ks) cf[ks] = *(const LAS bf16x8*)(Cn + (16 * w + fr) * LDK + 32 * ks + 8 * fq);
#pragma unroll
        for (int sb = 0; sb < 8; ++sb) { cb[sb] = (f32x4){0.f, 0.f, 0.f, 0.f};
#pragma unroll
            for (int ks = 0; ks < 4; ++ks) { const bf16x8 bf = *(const LAS bf16x8*)(Bn + (16 * sb + fr) * LDK + 32 * ks + 8 * fq); cb[sb] = MFMA16(cf[ks], bf, cb[sb]); } } }
    float ssq[4] = {0.f, 0.f, 0.f, 0.f};
    const bf16* SIN = (const bf16*)(A.ws + WS_SIN);
    bf16* YM = (bf16*)(A.ws + WS_YM);
#pragma unroll 1
    for (int r = 0; r < 8; ++r) {
        const int h = g * 8 + r;
        if (r) __syncthreads();
#pragma unroll 1
        for (int i = 0; i < 2; ++i) { const int task = tid + 512 * i, s = task >> 3, pc = task & 7; float o[8];
            conv8(H, seq0, c * 128 + s, h * 64 + pc * 8, A.in[I_CW], A.in[I_CB], nullptr, o);
            const float dt = DTL[r * 128 + s];
#pragma unroll
            for (int e = 0; e < 8; ++e) { XR[(pc * 8 + e) * LDK + s] = (bf16)f2bf(o[e]); XT[(pc * 8 + e) * LDK + s] = (bf16)f2bf(o[e] * dt); } }
        {   float al[4];
#pragma unroll
            for (int j = 0; j < 4; ++j) al[j] = ACSL[r * 128 + 16 * w + 4 * fq + j];
#pragma unroll
            for (int sb = 0; sb < 8; ++sb) { const int s = 16 * sb + fr; const float as = ACSL[r * 128 + s];
#pragma unroll
                for (int j = 0; j < 4; ++j) { const int l = 16 * w + 4 * fq + j; const float v = (s <= l) ? cb[sb][j] * __expf(al[j] - as) : 0.f;
                    Mw[(w * 16 + 4 * fq + j) * LDK + s] = (bf16)f2bf(v); } } }
        __syncthreads();
        f32x4 acc[4];
        {
            const bf16* sin = SIN + ((((size_t)b * 16 + c) * 32 + h) * 64) * 128;
#pragma unroll
            for (int pb = 0; pb < 4; ++pb) acc[pb] = (f32x4){0.f, 0.f, 0.f, 0.f};
#pragma unroll
            for (int ks = 0; ks < 4; ++ks) { const bf16x8 a = *(const LAS bf16x8*)(Cn + (16 * w + fr) * LDK + 32 * ks + 8 * fq);
#pragma unroll
                for (int pb = 0; pb < 4; ++pb) { const bf16x8 bf = *(const bf16x8*)(sin + (16 * pb + fr) * 128 + 32 * ks + 8 * fq); acc[pb] = MFMA16(a, bf, acc[pb]); } }
#pragma unroll
            for (int j = 0; j < 4; ++j) { const float e = __expf(ACSL[r * 128 + 16 * w + 4 * fq + j]);
#pragma unroll
                for (int pb = 0; pb < 4; ++pb) acc[pb][j] *= e; }
        }
#pragma unroll
        for (int ks = 0; ks < 4; ++ks) if (32 * ks < 16 * (w + 1)) { const bf16x8 a = *(const LAS bf16x8*)(Mw + (w * 16 + fr) * LDK + 32 * ks + 8 * fq);
#pragma unroll
            for (int pb = 0; pb < 4; ++pb) { const bf16x8 bf = *(const LAS bf16x8*)(XT + (16 * pb + fr) * LDK + 32 * ks + 8 * fq); acc[pb] = MFMA16(a, bf, acc[pb]); } }
        const float Dh = A.in[I_D][h];
#pragma unroll
        for (int pb = 0; pb < 4; ++pb)
#pragma unroll
            for (int j = 0; j < 4; ++j) { const int l = 16 * w + 4 * fq + j, p = 16 * pb + fr;
                const float z = bf2f(H[(row0 + l) * NIN + C_Z + h * 64 + p]);
                const float y = (acc[pb][j] + Dh * bf2f(XR[p * LDK + l])) * silu_f(z);
                ssq[j] += y * y; YM[(row0 + l) * 4096 + h * 64 + p] = (bf16)f2bf(y); }
    }
    float rstd[4];
#pragma unroll
    for (int j = 0; j < 4; ++j) { float s = ssq[j]; s += __shfl_xor(s, 1); s += __shfl_xor(s, 2); s += __shfl_xor(s, 4); s += __shfl_xor(s, 8); rstd[j] = rsqrtf(s * (1.f / 512.f) + EPS); }
    asm volatile("s_waitcnt vmcnt(0)" ::: "memory");
#pragma unroll 1
    for (int r = 0; r < 8; ++r)
#pragma unroll
        for (int pb = 0; pb < 4; ++pb) { const int col = (g * 8 + r) * 64 + 16 * pb + fr; const float gn = A.in[I_SSDN][col];
#pragma unroll
            for (int j = 0; j < 4; ++j) { bf16* yp = YM + (row0 + 16 * w + 4 * fq + j) * 4096 + col; *yp = (bf16)f2bf(bf2f(*(volatile bf16*)yp) * rstd[j] * gn); } }
}

DI void phase_norm_rows(const Frame& F, const Args& A, const float* gain) {
    const int gw = F.vcu * NWAVES + F.wave, NGW = F.G * NWAVES;
    for (int m = gw; m < NTOK; m += NGW) rms_row_to_bf16((const float*)(A.ws + WS_X1) + (size_t)m * DM, gain, (bf16*)(A.ws + WS_XN) + (size_t)m * DM, F.lane);
}

constexpr int LDP = 264;
DI void attn_prompt_unit(const Frame& F, const Args& A, int unit) {
    const int qb = unit & 15, h = (unit >> 4) & 3, b = unit >> 6;
    const int lane = F.lane, w = F.wave, fr = lane & 15, fq = lane >> 4;
    const bf16* QB = (const bf16*)(A.ws + WS_QB); const bf16* KP = (const bf16*)(A.ws + WS_KP); const bf16* VPT = (const bf16*)(A.ws + WS_VPT); bf16* OB = (bf16*)(A.ws + WS_OB);
    LAS bf16* Pw = (LAS bf16*)(F.lds) + w * 16 * LDP;
    const size_t qrow0 = (size_t)b * SEQ + qb * 128 + 16 * w;
    __syncthreads();
    f32x4 s[16];
#pragma unroll
    for (int kb = 0; kb < 16; ++kb) s[kb] = (f32x4){0.f, 0.f, 0.f, 0.f};
    const bf16* qp = QB + (qrow0 + fr) * DM + h * 512 + 8 * fq;
    const bf16* kp = KP + ((size_t)b * 256 + fr) * DM + h * 512 + 8 * fq;
#pragma unroll 2
    for (int ks = 0; ks < 16; ++ks) { const bf16x8 a = *(const bf16x8*)(qp + 32 * ks);
#pragma unroll
        for (int kb = 0; kb < 16; ++kb) { const bf16x8 bf = *(const bf16x8*)(kp + (size_t)(16 * kb) * DM + 32 * ks); s[kb] = MFMA16(a, bf, s[kb]); } }
    const float scale = 0.044194173824159216f;
    float mx[4], sm[4];
#pragma unroll
    for (int j = 0; j < 4; ++j) { float m = s[0][j];
#pragma unroll
        for (int kb = 1; kb < 16; ++kb) m = fmaxf(m, s[kb][j]);
        m = fmaxf(m, __shfl_xor(m, 1)); m = fmaxf(m, __shfl_xor(m, 2)); m = fmaxf(m, __shfl_xor(m, 4)); m = fmaxf(m, __shfl_xor(m, 8)); mx[j] = m; sm[j] = 0.f; }
#pragma unroll
    for (int kb = 0; kb < 16; ++kb)
#pragma unroll
        for (int j = 0; j < 4; ++j) { const float p = __expf((s[kb][j] - mx[j]) * scale); sm[j] += p; Pw[(4 * fq + j) * LDP + 16 * kb + fr] = (bf16)f2bf(p); }
#pragma unroll
    for (int j = 0; j < 4; ++j) { float t = sm[j]; t += __shfl_xor(t, 1); t += __shfl_xor(t, 2); t += __shfl_xor(t, 4); t += __shfl_xor(t, 8); sm[j] = 1.f / t; }
    __syncthreads();
    const bf16* vp = VPT + ((size_t)b * 2048 + h * 512 + fr) * 256 + 8 * fq;
#pragma unroll 1
    for (int dg = 0; dg < 4; ++dg) {
        f32x4 o[8];
#pragma unroll
        for (int db = 0; db < 8; ++db) o[db] = (f32x4){0.f, 0.f, 0.f, 0.f};
#pragma unroll 2
        for (int ks = 0; ks < 8; ++ks) { const bf16x8 a = *(const LAS bf16x8*)(Pw + fr * LDP + 32 * ks + 8 * fq);
#pragma unroll
            for (int db = 0; db < 8; ++db) { const bf16x8 bf = *(const bf16x8*)(vp + (size_t)(dg * 128 + 16 * db) * 256 + 32 * ks); o[db] = MFMA16(a, bf, o[db]); } }
#pragma unroll
        for (int db = 0; db < 8; ++db)
#pragma unroll
            for (int j = 0; j < 4; ++j) OB[(qrow0 + 4 * fq + j) * DM + h * 512 + dg * 128 + 16 * db + fr] = (bf16)f2bf(o[db][j] * sm[j]);
    }
}
DI void attn_sample_unit(const Frame& F, const Args& A, int unit) {
    const int h = unit & 3, b = unit >> 2;
    const int lane = F.lane, w = F.wave, tid = F.tid;
    LAS float* QS = (LAS float*)(F.lds);
    LAS float* RED = (LAS float*)(F.lds + 16384);
    LAS float* P = (LAS float*)(F.lds + 16384 + 65536);
    const bf16* QB = (const bf16*)(A.ws + WS_QB); bf16* OB = (bf16*)(A.ws + WS_OB);
    const size_t row0 = (size_t)TPR + (size_t)b * LSM;
    __syncthreads();
    const float scale = 0.044194173824159216f;
    for (int e = tid; e < 8 * 512; e += NTHR) QS[e] = bf2f(QB[(row0 + (e >> 9)) * DM + h * 512 + (e & 511)]) * scale;
    __syncthreads();
    const float* CK = A.in[I_CK] + ((size_t)b * 256 * 4 + h) * 512 + 64 * w;
#pragma unroll 1
    for (int kg = 0; kg < 4; ++kg) { const int m = lane + 64 * kg; const float* kp = CK + (size_t)m * 2048;
        float acc[8];
#pragma unroll
        for (int t = 0; t < 8; ++t) acc[t] = 0.f;
#pragma unroll 4
        for (int dd = 0; dd < 16; ++dd) { const f32x4 kv = *(const f32x4*)(kp + 4 * dd);
#pragma unroll
            for (int t = 0; t < 8; ++t) { const f32x4 q = *(const LAS f32x4*)(QS + t * 512 + 64 * w + 4 * dd); acc[t] += kv.x * q.x + kv.y * q.y + kv.z * q.z + kv.w * q.w; } }
#pragma unroll
        for (int t = 0; t < 8; ++t) RED[(w * 8 + t) * 256 + m] = acc[t]; }
    __syncthreads();
    {
        float v[4]; float mx = -3.0e38f;
#pragma unroll
        for (int i = 0; i < 4; ++i) { float s = 0.f;
#pragma unroll
            for (int ww = 0; ww < 8; ++ww) s += RED[(ww * 8 + w) * 256 + lane + 64 * i];
            v[i] = s; mx = fmaxf(mx, s); }
#pragma unroll
        for (int o = 1; o < 64; o <<= 1) mx = fmaxf(mx, __shfl_xor(mx, o));
        float sum = 0.f;
#pragma unroll
        for (int i = 0; i < 4; ++i) { v[i] = __expf(v[i] - mx); sum += v[i]; }
        const float inv = 1.f / wave_sum(sum);
#pragma unroll
        for (int i = 0; i < 4; ++i) P[(lane + 64 * i) * 8 + w] = v[i] * inv;
    }
    __syncthreads();
    {   const float* CV = A.in[I_CV] + ((size_t)b * 256 * 4 + h) * 512 + 64 * w + lane;
        float acc[8];
#pragma unroll
        for (int t = 0; t < 8; ++t) acc[t] = 0.f;
#pragma unroll 8
        for (int m = 0; m < 256; ++m) { const float v = CV[(size_t)m * 2048]; const f32x4 p0 = *(const LAS f32x4*)(P + m * 8), p1 = *(const LAS f32x4*)(P + m * 8 + 4);
            acc[0] += p0.x * v; acc[1] += p0.y * v; acc[2] += p0.z * v; acc[3] += p0.w * v; acc[4] += p1.x * v; acc[5] += p1.y * v; acc[6] += p1.z * v; acc[7] += p1.w * v; }
#pragma unroll
        for (int t = 0; t < 8; ++t) OB[(row0 + t) * DM + h * 512 + 64 * w + lane] = (bf16)f2bf(acc[t]);
    }
}

DI unsigned ord_f(float f) { const unsigned u = __builtin_bit_cast(unsigned, f); return (u & 0x80000000u) ? ~u : (u | 0x80000000u); }
DI float unord_f(unsigned k) { const unsigned u = (k & 0x80000000u) ? (k ^ 0x80000000u) : ~k; return __builtin_bit_cast(float, u); }
DI void peer_topk_unit(const Args& A, int unit, int lane) {
    const int h = unit & 7, tok0 = (unit >> 3) * 16, fr = lane & 15, fq = lane >> 4;
    const bf16* PQ = (const bf16*)(A.ws + WS_QB); const bf16* SK = (const bf16*)(A.ws + WS_SK);
    unsigned my1[4], top2[16];
#pragma unroll
    for (int i = 0; i < 2; ++i) {
        f32x4 acc[8];
#pragma unroll
        for (int kb = 0; kb < 8; ++kb) acc[kb] = (f32x4){0.f, 0.f, 0.f, 0.f};
#pragma unroll 1
        for (int ks = 0; ks < 4; ++ks) { const bf16x8 bt = *(const bf16x8*)(PQ + (size_t)(tok0 + fr) * DM + h * 256 + i * 128 + 32 * ks + 8 * fq);
#pragma unroll
            for (int kb = 0; kb < 8; ++kb) { const bf16x8 ak = *(const bf16x8*)(SK + ((size_t)(h * 2 + i) * 128 + 16 * kb + fr) * 128 + 32 * ks + 8 * fq); acc[kb] = MFMA16(ak, bt, acc[kb]); } }
        unsigned pk[32];
#pragma unroll
        for (int kb = 0; kb < 8; ++kb)
#pragma unroll
            for (int j = 0; j < 4; ++j) pk[kb * 4 + j] = (ord_f(acc[kb][j]) & ~127u) | (unsigned)(127 - (16 * kb + 4 * fq + j));
        unsigned prev = 0xFFFFFFFFu;
#pragma unroll
        for (int r = 0; r < 16; ++r) { unsigned loc = 0u;
#pragma unroll
            for (int e = 0; e < 32; ++e) { const unsigned cnd = pk[e] < prev ? pk[e] : 0u; loc = loc > cnd ? loc : cnd; }
            unsigned o = (unsigned)__shfl_xor((int)loc, 16); loc = loc > o ? loc : o; o = (unsigned)__shfl_xor((int)loc, 32); loc = loc > o ? loc : o;
            prev = loc;
            if (i == 0) { if ((r & 3) == 0) my1[r >> 2] = loc; else my1[r >> 2] = (fq == (r & 3)) ? loc : my1[r >> 2]; }
            else top2[r] = loc; }
    }
    float s1[4], s2[16];
#pragma unroll
    for (int sl = 0; sl < 4; ++sl) s1[sl] = unord_f(my1[sl] & ~127u);
#pragma unroll
    for (int bb = 0; bb < 16; ++bb) s2[bb] = unord_f(top2[bb] & ~127u);
    float cs[21]; unsigned ck[21];
#pragma unroll
    for (int ci = 0; ci < 21; ++ci) { const int sl = ci < 16 ? 0 : (ci < 19 ? 1 : (ci < 20 ? 2 : 3)), bb = ci < 16 ? ci : (ci < 19 ? ci - 16 : 0);
        cs[ci] = s1[sl] + s2[bb]; ck[ci] = (ord_f(cs[ci]) & ~127u) | (unsigned)(127 - (fq * 21 + ci)); }
    unsigned prev = 0xFFFFFFFFu, first = 0u;
#pragma unroll
    for (int r = 0; r < 16; ++r) { unsigned loc = 0u;
#pragma unroll
        for (int ci = 0; ci < 21; ++ci) { const unsigned cnd = ck[ci] < prev ? ck[ci] : 0u; loc = loc > cnd ? loc : cnd; }
        unsigned o = (unsigned)__shfl_xor((int)loc, 16); loc = loc > o ? loc : o; o = (unsigned)__shfl_xor((int)loc, 32); loc = loc > o ? loc : o;
        prev = loc; if (r == 0) first = loc; }
    const float mx = unord_f(first & ~127u);
    float ev[21]; float esum = 0.f; int cnt = 0;
#pragma unroll
    for (int ci = 0; ci < 21; ++ci) { const bool sel = ck[ci] >= prev; ev[ci] = sel ? __expf(cs[ci] - mx) : 0.f; esum += ev[ci]; cnt += sel ? 1 : 0; }
    esum += __shfl_xor(esum, 16); esum += __shfl_xor(esum, 32);
    const float inv = 1.f / esum;
    const int c0 = __shfl(cnt, fr), c1 = __shfl(cnt, fr + 16), c2 = __shfl(cnt, fr + 32);
    int pos = (fq > 0 ? c0 : 0) + (fq > 1 ? c1 : 0) + (fq > 2 ? c2 : 0);
    int* EID = (int*)(A.ws + WS_EID) + (size_t)(tok0 + fr) * 128 + h * 16; float* GATE = (float*)(A.ws + WS_GATE) + (size_t)(tok0 + fr) * 128 + h * 16;
#pragma unroll
    for (int ci = 0; ci < 21; ++ci) { const int sl = ci < 16 ? 0 : (ci < 19 ? 1 : (ci < 20 ? 2 : 3)), bb = ci < 16 ? ci : (ci < 19 ? ci - 16 : 0);
        if (ck[ci] >= prev) { const int i1 = 127 - (int)(my1[sl] & 127u), i2 = 127 - (int)(top2[bb] & 127u);
            if (pos < 16) { EID[pos] = i1 * 128 + i2; GATE[pos] = ev[ci] * inv; } ++pos; } }
}
DI float dot2bf(unsigned a, unsigned b, float c) { const unsigned a_ = a, b_ = b; return __builtin_amdgcn_fdot2_f32_bf16(__builtin_bit_cast(bf16x2_t, a_), __builtin_bit_cast(bf16x2_t, b_), c, false); }
DI float gelu_erf(float x) { return 0.5f * x * (1.0f + erff(x * 0.70710678118654752f)); }
DI void peer_gather_token(const Args& A, int t, int lane) {
    const bf16* U = (const bf16*)(A.ws + WS_U); const bf16* V = (const bf16*)(A.ws + WS_V);
    const v4u* xr = (const v4u*)((const bf16*)(A.ws + WS_XN) + (size_t)t * DM) + lane;
    v4u xv[4];
#pragma unroll
    for (int c = 0; c < 4; ++c) xv[c] = xr[64 * c];
    const int* EID = (const int*)(A.ws + WS_EID) + (size_t)t * 128; const float* GATE = (const float*)(A.ws + WS_GATE) + (size_t)t * 128;
    float out[32];
#pragma unroll
    for (int e = 0; e < 32; ++e) out[e] = 0.f;
#ifndef DBG_NOPEER
#define DBG_NOPEER 0
#endif
#pragma unroll 1
    for (int half = 0; half < (DBG_NOPEER ? 0 : 2); ++half) {
        const int myeid = EID[half * 64 + lane]; const float mygate = GATE[half * 64 + lane];
        float myact = 0.f;
#pragma unroll 1
        for (int k = 0; k < 64; k += 4) {
            float d[4];
#pragma unroll
            for (int q = 0; q < 4; ++q) { const int e = __builtin_amdgcn_readlane(myeid, k + q); const v4u* up = (const v4u*)(U + (size_t)e * DM) + lane; float a = 0.f;
#pragma unroll
                for (int c = 0; c < 4; ++c) { const v4u uv = up[64 * c];
                    a = dot2bf(xv[c].x, uv.x, a); a = dot2bf(xv[c].y, uv.y, a); a = dot2bf(xv[c].z, uv.z, a); a = dot2bf(xv[c].w, uv.w, a); }
                d[q] = a; }
#pragma unroll
            for (int q = 0; q < 4; ++q) { const float s = wave_sum(d[q]); myact = (lane == k + q) ? s : myact; }
        }
        const float mywgt = mygate * gelu_erf(myact);
#pragma unroll 1
        for (int k = 0; k < 64; k += 2) {
#pragma unroll
            for (int q = 0; q < 2; ++q) { const int e = __builtin_amdgcn_readlane(myeid, k + q); const float wg = __builtin_bit_cast(float, __builtin_amdgcn_readlane(__builtin_bit_cast(int, mywgt), k + q));
                const v4u* vp = (const v4u*)(V + (size_t)e * DM) + lane;
#pragma unroll
                for (int c = 0; c < 4; ++c) { const v4u vv = vp[64 * c];
                    out[c * 8 + 0] += wg * bflo(vv.x); out[c * 8 + 1] += wg * bfhi(vv.x); out[c * 8 + 2] += wg * bflo(vv.y); out[c * 8 + 3] += wg * bfhi(vv.y);
                    out[c * 8 + 4] += wg * bflo(vv.z); out[c * 8 + 5] += wg * bfhi(vv.z); out[c * 8 + 6] += wg * bflo(vv.w); out[c * 8 + 7] += wg * bfhi(vv.w); } }
        }
    }
    const float* x2 = (const float*)(A.ws + WS_X1) + (size_t)t * DM; float ss = 0.f;
#pragma unroll
    for (int c = 0; c < 4; ++c) { const f32x4 a0 = *(const f32x4*)(x2 + 512 * c + 8 * lane), a1 = *(const f32x4*)(x2 + 512 * c + 8 * lane + 4);
        out[c * 8 + 0] += a0.x; out[c * 8 + 1] += a0.y; out[c * 8 + 2] += a0.z; out[c * 8 + 3] += a0.w; out[c * 8 + 4] += a1.x; out[c * 8 + 5] += a1.y; out[c * 8 + 6] += a1.z; out[c * 8 + 7] += a1.w;
#pragma unroll
        for (int e = 0; e < 8; ++e) ss += out[c * 8 + e] * out[c * 8 + e]; }
    const float r = rsqrtf(wave_sum(ss) * (1.f / DM) + EPS);
    float* yo = A.out + (t < TPR ? O_YP + (size_t)t * DM : O_YS + (size_t)(t - TPR) * DM); const float* gn = A.in[I_NF];
#pragma unroll
    for (int c = 0; c < 4; ++c) { const f32x4 g0 = *(const f32x4*)(gn + 512 * c + 8 * lane), g1 = *(const f32x4*)(gn + 512 * c + 8 * lane + 4);
        *(f32x4*)(yo + 512 * c + 8 * lane) = (f32x4){out[c * 8 + 0] * r * g0.x, out[c * 8 + 1] * r * g0.y, out[c * 8 + 2] * r * g0.z, out[c * 8 + 3] * r * g0.w};
        *(f32x4*)(yo + 512 * c + 8 * lane + 4) = (f32x4){out[c * 8 + 4] * r * g1.x, out[c * 8 + 5] * r * g1.y, out[c * 8 + 6] * r * g1.z, out[c * 8 + 7] * r * g1.w}; }
}

constexpr int NPHASE = 14;
__global__ void __launch_bounds__(NTHR, 2) hymba_fwd(Args args) {
    extern __shared__ __attribute__((aligned(16))) unsigned char lds[];
    Frame F;
    F.lds = (LAS unsigned char*)lds;
    F.tid = threadIdx.x; F.lane = F.tid & 63; F.wave = __builtin_amdgcn_readfirstlane(F.tid >> 6);
    F.G = gridDim.x; { const int bx = blockIdx.x; F.vcu = (F.G % 8 == 0) ? (bx % 8) * (F.G / 8) + bx / 8 : bx; }
    volatile LAS unsigned* MISC = (volatile LAS unsigned*)(F.lds + MISC_OFF);
    if (F.tid < 64) MISC[F.tid] = 0u;
    __syncthreads();
    unsigned char* ws = args.ws;
    XcdBarrier bar; bar.bar = (unsigned*)(ws + WS_CTL) + CW_BAR; bar.x = 0; bar.st = nullptr;
    const int lo = args.ph_lo, hi = args.ph_hi;
    if (hi - lo > 1) bar = xcd_barrier_post((unsigned*)(ws + WS_CTL) + CW_BAR, MISC + 8);
#ifndef PHASE_MASK
#define PHASE_MASK 0xFFFF
#endif
#define IN(k) (((PHASE_MASK >> (k)) & 1) && lo <= (k) && (k) < hi)
#define SEAM(k) do { if (IN(k) && IN((k) + 1)) xcd_barrier(bar); } while (0)
    const int gw = F.vcu * NWAVES + F.wave, NGW = F.G * NWAVES;

    if (IN(0)) { phase_prologue(F, args); } SEAM(0);

    if (IN(1)) {
        { pg8::Gemm g{(const bf16*)(ws + WS_XN), (const bf16*)(ws + WS_WIN), NTOK, NIN, DM}; pg8::StaticOrder S; S.init(NTOK, NIN, F.G, (int)blockIdx.x);
          pg8::EpiBf16 E{(bf16*)(ws + WS_H), NIN};
          pg8::gemm_phase<pg8::EpiBf16, pg8::StaticOrder, true, true>(F.lds, g, S, E); }
        { pg8::Gemm g{(const bf16*)(ws + WS_MN), (const bf16*)(ws + WS_WKV), 1024, 4096, DM}; pg8::StaticOrder S; S.init(1024, 4096, F.G, (int)((blockIdx.x + F.G - 84 % F.G) % F.G));
          pg8::EpiKV E{args.out + O_PMK, args.out + O_PMV, (bf16*)(ws + WS_KP), (bf16*)(ws + WS_VPT)};
          pg8::gemm_phase<pg8::EpiKV, pg8::StaticOrder, true, true>(F.lds, g, S, E); }
    } SEAM(1);

    if (IN(2)) {
        for (int it = F.vcu; it < 256 + 512; it += F.G) { if (it < 256) ssd_pass1_item(F, args, it); else ssd_sample_item(F, args, it - 256); }
        short_conv_all(F, args);
    } SEAM(2);

    if (IN(3)) { ssd_propagate(F, args); } SEAM(3);

    if (IN(4)) { for (int it = F.vcu; it < 256; it += F.G) ssd_pass2_item(F, args, it); } SEAM(4);

    if (IN(5)) {
        pg8::Gemm g{(const bf16*)(ws + WS_YM), (const bf16*)(ws + WS_WOUT), NTOK, DM, 4096}; pg8::StaticOrder S; S.init(NTOK, DM, F.G, (int)blockIdx.x);
        pg8::EpiRes<true> E{(float*)(ws + WS_X1), args.in[I_XP], args.in[I_XS]};
        pg8::gemm_phase<pg8::EpiRes<true>, pg8::StaticOrder, true, true>(F.lds, g, S, E);
    } SEAM(5);

    if (IN(6)) { phase_norm_rows(F, args, args.in[I_NMQ]); } SEAM(6);

    if (IN(7)) {
        pg8::Gemm g{(const bf16*)(ws + WS_XN), (const bf16*)(ws + WS_WQ), NTOK, DM, DM}; pg8::StaticOrder S; S.init(NTOK, DM, F.G, (int)blockIdx.x);
        pg8::EpiBf16 E{(bf16*)(ws + WS_QB), DM};
        pg8::gemm_phase<pg8::EpiBf16, pg8::StaticOrder, true, true>(F.lds, g, S, E);
    } SEAM(7);

    if (IN(8)) { for (int it = F.vcu; it < 256 + 512; it += F.G) { if (it < 256) attn_prompt_unit(F, args, it); else attn_sample_unit(F, args, it - 256); } } SEAM(8);

    if (IN(9)) {
        pg8::Gemm g{(const bf16*)(ws + WS_OB), (const bf16*)(ws + WS_WO), NTOK, DM, DM}; pg8::StaticOrder S; S.init(NTOK, DM, F.G, (int)blockIdx.x);
        pg8::EpiRes<false> E{(float*)(ws + WS_X1), nullptr, nullptr};
        pg8::gemm_phase<pg8::EpiRes<false>, pg8::StaticOrder, true, true>(F.lds, g, S, E);
    } SEAM(9);

    if (IN(10)) { phase_norm_rows(F, args, args.in[I_NFFN]); } SEAM(10);

    if (IN(11)) {
        pg8::Gemm g{(const bf16*)(ws + WS_XN), (const bf16*)(ws + WS_WPQ), NTOK, DM, DM}; pg8::StaticOrder S; S.init(NTOK, DM, F.G, (int)blockIdx.x);
        pg8::EpiBf16 E{(bf16*)(ws + WS_QB), DM};
        pg8::gemm_phase<pg8::EpiBf16, pg8::StaticOrder, true, true>(F.lds, g, S, E);
    } SEAM(11);

    if (IN(12)) { for (int u = gw; u < (NTOK / 16) * 8; u += NGW) peer_topk_unit(args, u, F.lane); } SEAM(12);

    if (IN(13)) { for (int t = gw; t < NTOK; t += NGW) peer_gather_token(args, t, F.lane); }
#undef IN
#undef SEAM
}

extern "C" void kernel_launch(void* const* d_in, const int* in_sizes, int n_in, void* d_out, int out_size, void* d_ws, size_t ws_size, hipStream_t stream) {
    static int grid = 0;
    if (grid == 0) {
        if (n_in != 30 || out_size != (int)O_END || ws_size < WS_END) { fprintf(stderr, "kernel_launch: unexpected shapes: n_in %d out %d ws %zu (need %zu)\n", n_in, out_size, ws_size, (size_t)WS_END); grid = -1; return; }
        int dev = 0, cus = 0, per_cu = 0;
        if (hipGetDevice(&dev) != hipSuccess || hipDeviceGetAttribute(&cus, hipDeviceAttributeMultiprocessorCount, dev) != hipSuccess) { grid = -1; return; }
        if (hipFuncSetAttribute((const void*)hymba_fwd, hipFuncAttributeMaxDynamicSharedMemorySize, LDS_BYTES) != hipSuccess) { fprintf(stderr, "kernel_launch: hipFuncSetAttribute failed\n"); grid = -1; return; }
        if (hipOccupancyMaxActiveBlocksPerMultiprocessor(&per_cu, (const void*)hymba_fwd, NTHR, LDS_BYTES) != hipSuccess || per_cu < 1) { fprintf(stderr, "kernel_launch: occupancy query says %d\n", per_cu); }
        (void)hipGetLastError();
        grid = cus;
    }
    if (grid < 0) return;
    hipMemsetAsync((char*)d_ws + WS_CTL, 0, CTL_ZERO_BYTES, stream);
    Args a{};
    for (int i = 0; i < 30; ++i) a.in[i] = (const float*)d_in[i];
    a.out = (float*)d_out; a.ws = (unsigned char*)d_ws;
#if MK_ONE_LAUNCH
    a.ph_lo = 0; a.ph_hi = NPHASE;
    hipLaunchKernelGGL(hymba_fwd, dim3(grid), dim3(NTHR), LDS_BYTES, stream, a);
#else
    for (int p = 0; p < NPHASE; ++p) { a.ph_lo = p; a.ph_hi = p + 1; hipLaunchKernelGGL(hymba_fwd, dim3(grid), dim3(NTHR), LDS_BYTES, stream, a); }
#endif
}
```

```cpp
#include <hip/hip_runtime.h>
#include <cstdio>
#include <cstdint>

#ifndef MK_ONE_LAUNCH
#define MK_ONE_LAUNCH 1
#endif

namespace pg8 {
#define PG8_LAS __attribute__((address_space(3)))
typedef unsigned short bf16_t;
typedef short bf16x8 __attribute__((ext_vector_type(8)));
typedef float f32x4 __attribute__((ext_vector_type(4)));
typedef unsigned u32x4 __attribute__((ext_vector_type(4)));
constexpr int BM = 256, BK = 64, HALF = 128, HTB = HALF * BK * 2  , STAGE_BYTES = 8 * HTB, NXCD = 8, WGM = 8;

__host__ __device__ __forceinline__ int lds_byte(int r, int c) { const int st = (r >> 4) * 2 + (c >> 5), rr = r & 15, cc = c & 31, ob = rr * 64 + cc * 2; return st * 1024 + (ob ^ (((ob >> 9) & 1) << 5)); }
__host__ __device__ __forceinline__ void stage_rc(int b, int& R, int& C) { const int st = b / 1024, sb = b % 1024, swz = sb ^ (((sb >> 9) & 1) << 5); R = (st >> 1) * 16 + swz / 64; C = (st & 1) * 32 + (swz % 64) / 2; }
__host__ __device__ __forceinline__ int perm32(int rho) { const int n = rho >> 4, i = rho & 15; return 8 * (i >> 2) + 4 * n + (i & 3); }

struct Unit { int pm, pn; };
struct Gemm { const bf16_t* A; const bf16_t* Bt; int M, N, K; };

struct StaticOrder {
    int nM, nN, nwg, G, c;
    __host__ __device__ void init(int M, int N, int G_, int c_) { nM = M / BM; nN = N / BM; nwg = nM * nN; G = G_; c = c_; }
    __host__ __device__ bool next(int i, Unit& u) const {
        const long L = (long)i * G + c; if (L >= nwg) return false;
        int wgid = (int)L; { const int q = nwg / NXCD, r = nwg % NXCD, xcd = wgid % NXCD, off = wgid / NXCD; wgid = (xcd < r ? xcd * (q + 1) : r * (q + 1) + (xcd - r) * q) + off; }
        const int nig = WGM * nN, gid = wgid / nig, fm = gid * WGM, gsz = (nM - fm) < WGM ? (nM - fm) : WGM;
        u.pm = fm + ((wgid % nig) % gsz); u.pn = (wgid % nig) / gsz; return true;
    }
    __device__ __forceinline__ void a_ready(const Unit&) const {}
    __device__ __forceinline__ void done(const Unit&) const {}
};

__device__ __forceinline__ unsigned cvt_pk_bf16(float lo, float hi) { unsigned r; asm volatile("v_cvt_pk_bf16_f32 %0, %1, %2" : "=v"(r) : "v"(lo), "v"(hi)); return r; }

struct EpiBf16 {
    static constexpr bool PERM = true, AFTER_DRAIN = false;
    bf16_t* O; int ldc;
    __device__ __forceinline__ void operator()(const f32x4 (&acc)[2][2][4][2], const Unit& u, int wr, int wc, int fr, int fq) const {
        const int row0 = u.pm * BM + wr * 64 + fr; const int col0 = u.pn * BM + wc * 32 + 8 * fq;
#pragma unroll
        for (int ai = 0; ai < 2; ++ai)
#pragma unroll
            for (int m = 0; m < 4; ++m) { bf16_t* rowp = O + (size_t)(row0 + ai * HALF + m * 16) * ldc + col0;
#pragma unroll
                for (int bj = 0; bj < 2; ++bj) { const f32x4 v0 = acc[ai][bj][m][0], v1 = acc[ai][bj][m][1];
                    u32x4 w; w.x = cvt_pk_bf16(v0[0], v0[1]); w.y = cvt_pk_bf16(v0[2], v0[3]); w.z = cvt_pk_bf16(v1[0], v1[1]); w.w = cvt_pk_bf16(v1[2], v1[3]);
                    *(u32x4*)(rowp + bj * HALF) = w; } }
    }
};
struct EpiKV {
    static constexpr bool PERM = true, AFTER_DRAIN = false;
    float* outk; float* outv; bf16_t* kp; bf16_t* vpt;
    __device__ __forceinline__ void operator()(const f32x4 (&acc)[2][2][4][2], const Unit& u, int wr, int wc, int fr, int fq) const {
        const int row0 = u.pm * BM + wr * 64 + fr; const int colt = u.pn * BM; const bool isv = colt >= 2048; const int col0 = (colt & 2047) + wc * 32 + 8 * fq;
        float* of = isv ? outv : outk;
#pragma unroll
        for (int ai = 0; ai < 2; ++ai)
#pragma unroll
            for (int m = 0; m < 4; ++m) { const int row = row0 + ai * HALF + m * 16;
#pragma unroll
                for (int bj = 0; bj < 2; ++bj) { const f32x4 v0 = acc[ai][bj][m][0], v1 = acc[ai][bj][m][1]; const int col = col0 + bj * HALF;
                    float* op = of + (size_t)row * 2048 + col; *(f32x4*)op = v0; *(f32x4*)(op + 4) = v1;
                    u32x4 w; w.x = cvt_pk_bf16(v0[0], v0[1]); w.y = cvt_pk_bf16(v0[2], v0[3]); w.z = cvt_pk_bf16(v1[0], v1[1]); w.w = cvt_pk_bf16(v1[2], v1[3]);
                    if (!isv) { *(u32x4*)(kp + (size_t)row * 2048 + col) = w; }
                    else { const int b = row >> 8, mm = row & 255; bf16_t* tp = vpt + ((size_t)(b * 2048 + col)) * 256 + mm;
                        tp[0 * 256] = (bf16_t)(w.x & 0xffffu); tp[1 * 256] = (bf16_t)(w.x >> 16); tp[2 * 256] = (bf16_t)(w.y & 0xffffu); tp[3 * 256] = (bf16_t)(w.y >> 16);
                        tp[4 * 256] = (bf16_t)(w.z & 0xffffu); tp[5 * 256] = (bf16_t)(w.z >> 16); tp[6 * 256] = (bf16_t)(w.w & 0xffffu); tp[7 * 256] = (bf16_t)(w.w >> 16); } } }
    }
};
template <bool FIRST> struct EpiRes {
    static constexpr bool PERM = false, AFTER_DRAIN = false;
    float* X1; const float* xp; const float* xs;
    __device__ __forceinline__ void operator()(const f32x4 (&acc)[2][2][4][2], const Unit& u, int wr, int wc, int fr, int fq) const {
        const int row0 = u.pm * BM + wr * 64 + fr, col0 = u.pn * BM + wc * 32 + 4 * fq;
#pragma unroll
        for (int ai = 0; ai < 2; ++ai)
#pragma unroll
            for (int m = 0; m < 4; ++m) { const int row = row0 + ai * HALF + m * 16; float* rowp = X1 + (size_t)row * 2048 + col0;
                const float* bp = FIRST ? (row < 8192 ? xp + (size_t)row * 2048 : xs + (size_t)(row - 8192) * 2048) + col0 : rowp;
#pragma unroll
                for (int bj = 0; bj < 2; ++bj)
#pragma unroll
                    for (int n = 0; n < 2; ++n) { const f32x4 b = *(const f32x4*)(bp + bj * HALF + n * 16); *(f32x4*)(rowp + bj * HALF + n * 16) = acc[ai][bj][m][n] + b; } }
    }
};
template <class Epi, class Sched, bool ALIGN_EPI = false, bool SP2 = false>
__device__ __forceinline__ void gemm_phase(PG8_LAS unsigned char* lds, const Gemm g, const Sched& S, const Epi& E) {
    const int tid = threadIdx.x, wid = __builtin_amdgcn_readfirstlane(tid >> 6), lane = tid & 63, wr = wid >> 2, wc = wid & 3, fr = lane & 15, fq = lane >> 4;
    const int K = g.K, nt = K / BK;
    unsigned voffA[2], voffB[2];
#pragma unroll
    for (int i = 0; i < 2; ++i) { int R, C; stage_rc(tid * 16 + i * 8192, R, C); const int Rb = Epi::PERM ? ((R & ~31) + perm32(R & 31)) : R;
        voffA[i] = (unsigned)(R * K + C) * 2u; voffB[i] = (unsigned)(Rb * K + C) * 2u; }
    const size_t kstep = (size_t)(BK * 2);
    const size_t hstep = (size_t)HALF * K * 2;
    const size_t tstep = 2 * hstep;
    const unsigned ldsw = (unsigned)wid * 1024u;
    const int aoff = lds_byte(wr * 64 + fr, fq * 8), boff = lds_byte(wc * 32 + fr, fq * 8);
#define PG8_SA(b, h) (((b) * 2 + (h)) * HTB)
#define PG8_SB(b, h) ((4 + (b) * 2 + (h)) * HTB)
#define PG8_STAGE(bufoff, gbase, voff) do { _Pragma("unroll") for (int _i = 0; _i < 2; ++_i) \
        __builtin_amdgcn_global_load_lds((const unsigned*)((const char*)(gbase) + (voff)[_i]), (PG8_LAS unsigned*)(lds + (bufoff) + ldsw + _i * 8192), 16, 0, 0); } while (0)
#define PG8_LDA(dst, b, h) do { _Pragma("unroll") for (int m = 0; m < 4; ++m) _Pragma("unroll") for (int k = 0; k < 2; ++k) dst[m][k] = *(const PG8_LAS bf16x8*)(lds + PG8_SA(b, h) + aoff + m * 2048 + k * 1024); } while (0)
#define PG8_LDB(dst, b, h) do { _Pragma("unroll") for (int n = 0; n < 2; ++n) _Pragma("unroll") for (int k = 0; k < 2; ++k) dst[n][k] = *(const PG8_LAS bf16x8*)(lds + PG8_SB(b, h) + boff + n * 2048 + k * 1024); } while (0)
#define PG8_MMA(ai, bj, At, Bt) do { __builtin_amdgcn_s_setprio(1); _Pragma("unroll") for (int m = 0; m < 4; ++m) _Pragma("unroll") for (int n = 0; n < 2; ++n) _Pragma("unroll") for (int k = 0; k < 2; ++k) \
        acc[ai][bj][m][n] = __builtin_amdgcn_mfma_f32_16x16x32_bf16(Bt[n][k], At[m][k], acc[ai][bj][m][n], 0, 0, 0); __builtin_amdgcn_s_setprio(0); } while (0)
#define PG8_WAIT_V(n) asm volatile("s_waitcnt vmcnt(" #n ")" ::: "memory")
#define PG8_WAIT_L(n) asm volatile("s_waitcnt lgkmcnt(" #n ")" ::: "memory")
#define PG8_BAR __builtin_amdgcn_s_barrier()
#define PG8_SCHED __builtin_amdgcn_sched_barrier(0)
    Unit cur, nxt; int ui = 0;
    if (!S.next(0, cur)) return;
    f32x4 acc[2][2][4][2];
#pragma unroll
    for (int a = 0; a < 2; ++a)
#pragma unroll
        for (int b = 0; b < 2; ++b)
#pragma unroll
            for (int m = 0; m < 4; ++m)
#pragma unroll
                for (int n = 0; n < 2; ++n) acc[a][b][m][n] = (f32x4){0.f, 0.f, 0.f, 0.f};
    bf16x8 At[4][2], B0[2][2], B1[2][2];
    const char* cA = (const char*)g.A + (size_t)cur.pm * tstep; const char* cB = (const char*)g.Bt + (size_t)cur.pn * tstep;
    S.a_ready(cur);
    if constexpr (SP2) {
        PG8_STAGE(PG8_SB(0, 0), cB, voffB); PG8_STAGE(PG8_SB(0, 1), cB + hstep, voffB); PG8_STAGE(PG8_SA(0, 0), cA, voffA); PG8_STAGE(PG8_SA(0, 1), cA + hstep, voffA);
        if (wr == 1) PG8_BAR;
        PG8_WAIT_V(2); PG8_BAR;
        PG8_STAGE(PG8_SB(1, 0), cB + kstep, voffB); PG8_STAGE(PG8_SA(1, 0), cA + kstep, voffA); PG8_STAGE(PG8_SB(1, 1), cB + hstep + kstep, voffB);
        PG8_WAIT_V(6); PG8_BAR;
    } else {
        PG8_STAGE(PG8_SB(0, 0), cB, voffB); PG8_STAGE(PG8_SA(0, 0), cA, voffA); PG8_STAGE(PG8_SB(0, 1), cB + hstep, voffB); PG8_STAGE(PG8_SA(0, 1), cA + hstep, voffA);
        if (wr == 1) PG8_BAR;
        PG8_WAIT_V(4); PG8_BAR;
        PG8_STAGE(PG8_SB(1, 0), cB + kstep, voffB); PG8_STAGE(PG8_SA(1, 0), cA + kstep, voffA); PG8_STAGE(PG8_SB(1, 1), cB + hstep + kstep, voffB);
        PG8_WAIT_V(6); PG8_BAR;
    }
    for (;;) {
        const bool has_next = S.next(ui + 1, nxt);
        const char* nA = has_next ? (const char*)g.A + (size_t)nxt.pm * tstep : cA; const char* nB = has_next ? (const char*)g.Bt + (size_t)nxt.pn * tstep : cB;
        for (int t = 0; t < nt; t += 2) {
            const bool last = (t == nt - 2);
            const char* a1 = cA + (size_t)(t + 1) * kstep;
            const char* a2 = last ? nA : cA + (size_t)(t + 2) * kstep; const char* b2 = last ? nB : cB + (size_t)(t + 2) * kstep;
            const char* a3 = a2 + kstep; const char* b3 = b2 + kstep;
            if (last && has_next) S.a_ready(nxt);
            if constexpr (SP2) {
            PG8_LDB(B0, 0, 0); PG8_LDB(B1, 0, 1); PG8_SCHED; PG8_LDA(At, 0, 0); PG8_STAGE(PG8_SA(1, 1), a1 + hstep, voffA);
            PG8_WAIT_V(8); PG8_WAIT_L(0); PG8_BAR; PG8_MMA(0, 0, At, B0); PG8_MMA(0, 1, At, B1); PG8_BAR; PG8_SCHED;
            PG8_LDA(At, 0, 1); PG8_STAGE(PG8_SB(0, 0), b2, voffB); PG8_STAGE(PG8_SB(0, 1), b2 + hstep, voffB); PG8_STAGE(PG8_SA(0, 0), a2, voffA);
            PG8_WAIT_V(8); PG8_WAIT_L(0); PG8_BAR; PG8_MMA(1, 0, At, B0); PG8_MMA(1, 1, At, B1); PG8_BAR; PG8_SCHED;
            PG8_LDB(B0, 1, 0); PG8_LDB(B1, 1, 1); PG8_SCHED; PG8_LDA(At, 1, 0); PG8_STAGE(PG8_SA(0, 1), a2 + hstep, voffA);
            PG8_WAIT_V(8); PG8_WAIT_L(0); PG8_BAR; PG8_MMA(0, 0, At, B0); PG8_MMA(0, 1, At, B1); PG8_BAR; PG8_SCHED;
            PG8_LDA(At, 1, 1); PG8_STAGE(PG8_SB(1, 0), b3, voffB); PG8_STAGE(PG8_SB(1, 1), b3 + hstep, voffB); PG8_STAGE(PG8_SA(1, 0), a3, voffA);
            PG8_WAIT_V(8); PG8_WAIT_L(0); PG8_BAR; PG8_MMA(1, 0, At, B0); PG8_MMA(1, 1, At, B1); PG8_BAR; PG8_SCHED;
            } else {
            PG8_LDB(B0, 0, 0); PG8_SCHED; PG8_LDA(At, 0, 0); PG8_STAGE(PG8_SA(1, 1), a1 + hstep, voffA);
            PG8_WAIT_L(8); PG8_BAR; PG8_WAIT_L(0); PG8_MMA(0, 0, At, B0); PG8_BAR; PG8_SCHED;
            PG8_LDB(B1, 0, 1); PG8_STAGE(PG8_SB(0, 0), b2, voffB);
            PG8_BAR; PG8_WAIT_L(0); PG8_MMA(0, 1, At, B1); PG8_BAR;
            PG8_LDA(At, 0, 1); PG8_STAGE(PG8_SA(0, 0), a2, voffA);
            PG8_BAR; PG8_WAIT_L(0); PG8_MMA(1, 0, At, B0); PG8_BAR; PG8_SCHED;
            PG8_STAGE(PG8_SB(0, 1), b2 + hstep, voffB);
            PG8_WAIT_V(6); PG8_BAR; PG8_MMA(1, 1, At, B1); PG8_BAR;
            PG8_LDB(B0, 1, 0); PG8_SCHED; PG8_LDA(At, 1, 0); PG8_STAGE(PG8_SA(0, 1), a2 + hstep, voffA);
            PG8_WAIT_L(8); PG8_BAR; PG8_WAIT_L(0); PG8_MMA(0, 0, At, B0); PG8_BAR; PG8_SCHED;
            PG8_LDB(B1, 1, 1); PG8_STAGE(PG8_SB(1, 0), b3, voffB);
            PG8_BAR; PG8_WAIT_L(0); PG8_MMA(0, 1, At, B1); PG8_BAR;
            PG8_LDA(At, 1, 1); PG8_STAGE(PG8_SA(1, 0), a3, voffA);
            PG8_BAR; PG8_WAIT_L(0); PG8_MMA(1, 0, At, B0); PG8_BAR; PG8_SCHED;
            PG8_STAGE(PG8_SB(1, 1), b3 + hstep, voffB);
            PG8_WAIT_V(6); PG8_BAR; PG8_MMA(1, 1, At, B1); PG8_BAR;
            }
        }
        if constexpr (ALIGN_EPI) { if (wr == 0) PG8_BAR; }
        if constexpr (!Epi::AFTER_DRAIN) { E(acc, cur, wr, wc, fr, fq); S.done(cur); }
        if (!has_next) break;
#pragma unroll
        for (int a = 0; a < 2; ++a)
#pragma unroll
            for (int b = 0; b < 2; ++b)
#pragma unroll
                for (int m = 0; m < 4; ++m)
#pragma unroll
                    for (int n = 0; n < 2; ++n) acc[a][b][m][n] = (f32x4){0.f, 0.f, 0.f, 0.f};
        cur = nxt; cA = nA; cB = nB; ++ui;
        if constexpr (ALIGN_EPI) { if (wr == 1) PG8_BAR; }
    }
    PG8_WAIT_V(0);
    if constexpr (!ALIGN_EPI) { if (wr == 0) PG8_BAR; }
    PG8_BAR;
    if constexpr (Epi::AFTER_DRAIN) { E.fused(acc, cur, wr, wc, fr, fq, lds, wid, lane); S.done(cur); }
#undef PG8_SA
#undef PG8_SB
#undef PG8_STAGE
#undef PG8_LDA
#undef PG8_LDB
#undef PG8_MMA
#undef PG8_WAIT_V
#undef PG8_WAIT_L
#undef PG8_BAR
#undef PG8_SCHED
}
}

constexpr int DM = 2048, NTOK = 9216, TPR = 8192, SEQ = 2048, NBP = 4, NBS = 128, LSM = 8;
constexpr int NIN = 11520;
constexpr int C_Z = 0, C_XBC = 2048, C_DT = 5120, C_SCH = 5376, C_SCB = 7424, C_SCC = 9472;
constexpr int CONVD = 3072;
constexpr int NEXP = 16384;
constexpr float EPS = 1e-6f;
constexpr size_t O_YP = 0, O_YS = 16777216, O_PSSM = 18874368, O_PCONV = 19922944, O_PSC = 19959808, O_PMK = 19976192, O_PMV = 22073344,
                 O_SSSM = 24170496, O_SCONV = 57724928, O_SSC = 58904576, O_END = 59428864;
constexpr size_t al256(size_t x) { return (x + 255) & ~(size_t)255; }
constexpr size_t WS_CTL = 0, CTL_ZERO_BYTES = 1u << 20;
constexpr size_t WS_WIN = CTL_ZERO_BYTES;
constexpr size_t WS_WOUT = WS_WIN + (size_t)NIN * DM * 2;
constexpr size_t WS_WQ = WS_WOUT + (size_t)DM * 4096 * 2;
constexpr size_t WS_WKV = WS_WQ + (size_t)DM * DM * 2;
constexpr size_t WS_WO = WS_WKV + (size_t)4096 * DM * 2;
constexpr size_t WS_WPQ = WS_WO + (size_t)DM * DM * 2;
constexpr size_t WS_SK = WS_WPQ + (size_t)DM * DM * 2;
constexpr size_t WS_U = WS_SK + (size_t)8 * 2 * 128 * 128 * 2;
constexpr size_t WS_V = WS_U + (size_t)NEXP * DM;
constexpr size_t WS_USC = WS_V + (size_t)NEXP * DM;
constexpr size_t WS_VSC = WS_USC + (size_t)NEXP * 4;
constexpr size_t WS_XN = WS_VSC + (size_t)NEXP * 4;
constexpr size_t WS_MN = WS_XN + (size_t)NTOK * DM * 2;
constexpr size_t WS_H = WS_MN + (size_t)1024 * DM * 2;
constexpr size_t WS_YM = WS_H + (size_t)NTOK * NIN * 2;
constexpr size_t WS_X1 = WS_YM + (size_t)NTOK * 4096 * 2;
constexpr size_t WS_QB = WS_X1 + (size_t)NTOK * DM * 4;
constexpr size_t WS_OB = WS_QB + (size_t)NTOK * DM * 2;
constexpr size_t WS_KP = WS_OB + (size_t)NTOK * DM * 2;
constexpr size_t WS_VPT = WS_KP + (size_t)1024 * DM * 2;
constexpr size_t WS_SLOC = WS_VPT + (size_t)1024 * DM * 2;
constexpr size_t WS_SIN = WS_SLOC + (size_t)4 * 16 * 32 * 64 * 128 * 4;
constexpr size_t WS_DTB = WS_SIN + (size_t)4 * 16 * 32 * 64 * 128 * 2;
constexpr size_t WS_ACS = WS_DTB + (size_t)TPR * 32 * 4;
constexpr size_t WS_EID = WS_ACS + (size_t)TPR * 32 * 4;
constexpr size_t WS_GATE = WS_EID + (size_t)NTOK * 128 * 4;
constexpr size_t WS_END = WS_GATE + (size_t)NTOK * 128 * 4;
constexpr int CW_BAR = 4096, CW_PEERQ = 64;
constexpr int LDS_BYTES = 155648;
constexpr int MISC_OFF = 155648 - 256;
constexpr int NWAVES = 8, NTHR = 512;

#define GAS __attribute__((address_space(1)))
#define LAS __attribute__((address_space(3)))
#define DI __device__ __forceinline__
typedef unsigned short bf16;
typedef unsigned v4u __attribute__((ext_vector_type(4)));
typedef unsigned v2u __attribute__((ext_vector_type(2)));
typedef float f32x4 __attribute__((ext_vector_type(4)));
typedef float f32x2 __attribute__((ext_vector_type(2)));
typedef short bf16x8 __attribute__((ext_vector_type(8)));
typedef __bf16 bf16x2_t __attribute__((ext_vector_type(2)));
#define RLX_AGENT __ATOMIC_RELAXED, __HIP_MEMORY_SCOPE_AGENT
DI unsigned f2bf(float f) { unsigned u = __builtin_bit_cast(unsigned, f); return (u + 0x7fffu + ((u >> 16) & 1u)) >> 16; }
DI unsigned pk2(float lo, float hi) { return f2bf(lo) | (f2bf(hi) << 16); }
DI float bf2f(bf16 v) { return __builtin_bit_cast(float, (unsigned)v << 16); }
DI float bflo(unsigned w) { return __builtin_bit_cast(float, w << 16); }
DI float bfhi(unsigned w) { return __builtin_bit_cast(float, w & 0xffff0000u); }
DI float wave_sum(float v) {
#pragma unroll
    for (int o = 1; o < 64; o <<= 1) v += __shfl_xor(v, o);
    return v;
}
DI float silu_f(float v) { return v / (1.0f + __expf(-v)); }
DI float softplus_f(float x) { return fmaxf(x, 0.f) + log1pf(__expf(-fabsf(x))); }
#define MFMA16(a, b, c) __builtin_amdgcn_mfma_f32_16x16x32_bf16((a), (b), (c), 0, 0, 0)

#define XB_TMO      128
#define XB_XCNT(j)  (256  + 64 * (j))
#define XB_XSUB(j)  (1280 + 64 * (j))
#define XB_XGEN(j)  (2304 + 64 * (j))
#define XB_TOP      3328
#define XB_TOPGEN   3392
#define XCD_BAR_WORDS 3456
#define XB_SPIN_CAP (1u << 18)

__device__ __forceinline__ unsigned xb_ld(unsigned* p)              { return __hip_atomic_load(p, __ATOMIC_RELAXED, __HIP_MEMORY_SCOPE_AGENT); }
__device__ __forceinline__ unsigned xb_add(unsigned* p, unsigned v) { return __hip_atomic_fetch_add(p, v, __ATOMIC_RELAXED, __HIP_MEMORY_SCOPE_AGENT); }
__device__ __forceinline__ unsigned xb_xcc_id() { return (unsigned)__builtin_amdgcn_s_getreg((3 << 11) | 20) & 0xFu; }
#define XB_SPIN(cond, bar) do { unsigned _sp = 0; while (cond) { __builtin_amdgcn_s_sleep(1); \
    if ((++_sp & 255u) == 0u) { if (xb_ld(&(bar)[XB_TMO])) break; if (_sp > XB_SPIN_CAP) { atomicAdd(&(bar)[XB_TMO], 1u); break; } } } } while (0)

struct XcdBarrier {
    unsigned* bar; unsigned x;
    volatile LAS unsigned* st;
};
__device__ __forceinline__ XcdBarrier xcd_barrier_post(unsigned* bar, volatile LAS unsigned* st) {
    XcdBarrier b; b.bar = bar; b.x = xb_xcc_id(); b.st = st;
    if (threadIdx.x == 0) (void)xb_add(&bar[XB_XCNT(b.x)], 1u);
    return b;
}
__device__ __forceinline__ void xcd_barrier_complete(unsigned* bar, unsigned x, unsigned& nloc, unsigned& nx) {
    const unsigned G = gridDim.x * gridDim.y * gridDim.z;
    unsigned sum, cnt, mine, sp = 0u;
    for (;;) {
        sum = 0u; cnt = 0u; mine = 0u;
#pragma unroll
        for (unsigned j = 0; j < 16; ++j) { const unsigned c = xb_ld(&bar[XB_XCNT(j)]); sum += c; cnt += (c > 0u) ? 1u : 0u; mine = (j == x) ? c : mine; }
        if (sum == G) break;
        __builtin_amdgcn_s_sleep(1);
        if ((++sp & 255u) == 0u) { if (xb_ld(&bar[XB_TMO])) break; if (sp > XB_SPIN_CAP) { atomicAdd(&bar[XB_TMO], 1u); break; } }
    }
    nloc = mine > 0u ? mine : 1u; nx = cnt > 0u ? cnt : 1u;
}
__device__ __forceinline__ void xcd_barrier(const XcdBarrier& b) {
    asm volatile("s_waitcnt vmcnt(0)" ::: "memory");
    __syncthreads();
    if (threadIdx.x == 0) {
        unsigned* bar = b.bar;
        __builtin_amdgcn_s_waitcnt(0);
        unsigned nloc = b.st[0], nx = b.st[1];
        if (nloc == 0u) { xcd_barrier_complete(bar, b.x, nloc, nx); b.st[0] = nloc; b.st[1] = nx; }
        const unsigned old = xb_add(&bar[XB_XSUB(b.x)], 1u);
        const unsigned gen = old / nloc;
        if (old + 1u == (gen + 1u) * nloc) {
            __builtin_amdgcn_fence(__ATOMIC_RELEASE, "agent");
            asm volatile("s_waitcnt vmcnt(0)" ::: "memory");
            const unsigned og = xb_add(&bar[XB_TOP], 1u);
            const unsigned tg = og / nx;
            if (og + 1u == (tg + 1u) * nx) xb_add(&bar[XB_TOPGEN], 1u);
            else XB_SPIN(xb_ld(&bar[XB_TOPGEN]) == tg, bar);
            __builtin_amdgcn_fence(__ATOMIC_ACQUIRE, "agent");
            xb_add(&bar[XB_XGEN(b.x)], 1u);
            asm volatile("s_waitcnt vmcnt(0)" ::: "memory");
        } else {
            XB_SPIN(xb_ld(&bar[XB_XGEN(b.x)]) == gen, bar);
            __builtin_amdgcn_fence(__ATOMIC_ACQUIRE, "agent");
            asm volatile("s_waitcnt vmcnt(0)" ::: "memory");
        }
    }
    __syncthreads();
}

struct Args { const float* in[30]; float* out; unsigned char* ws; int ph_lo, ph_hi; };
struct Frame {
    LAS unsigned char* lds;
    int tid, lane, wave;
    int vcu, G;
};
enum { I_XP = 0, I_XS, I_MEM, I_SSM, I_SCONV, I_SSC, I_CK, I_CV, I_NMIX, I_WIN, I_CW, I_CB, I_DTB, I_ALOG, I_D, I_SSDN, I_SCW, I_WOUT, I_NMQ, I_NMKV,
       I_WMQ, I_WMK, I_WMV, I_WMO, I_NFFN, I_WPQ, I_SK, I_U, I_V, I_NF };

DI void p0_transpose_item(const float* W, int N, int K, bf16* WT, int k0, int n0, int dst_row0, LAS float* scr, int lane) {
#pragma unroll 8
    for (int i = 0; i < 32; ++i) { const int kk = 2 * i + (lane >> 5); scr[kk * 33 + (lane & 31)] = W[(size_t)(k0 + kk) * N + n0 + (lane & 31)]; }
    asm volatile("s_waitcnt lgkmcnt(0)" ::: "memory");
    const int c = lane & 7;
#pragma unroll
    for (int j = 0; j < 4; ++j) { const int n = (lane >> 3) + 8 * j; const LAS float* s = scr + (8 * c) * 33 + n;
        v4u o; o.x = pk2(s[0 * 33], s[1 * 33]); o.y = pk2(s[2 * 33], s[3 * 33]); o.z = pk2(s[4 * 33], s[5 * 33]); o.w = pk2(s[6 * 33], s[7 * 33]);
        *(v4u*)(WT + (size_t)(dst_row0 + n) * K + k0 + 8 * c) = o; }
    asm volatile("s_waitcnt lgkmcnt(0)" ::: "memory");
}
DI void rms_row_to_bf16(const float* xrow, const float* gain, bf16* orow, int lane) {
    const f32x4* xr = (const f32x4*)xrow + lane;
    f32x4 v[8]; float s = 0.f;
#pragma unroll
    for (int j = 0; j < 8; ++j) { v[j] = xr[64 * j]; s += (v[j].x * v[j].x + v[j].y * v[j].y) + (v[j].z * v[j].z + v[j].w * v[j].w); }
    const float r = rsqrtf(wave_sum(s) * (1.f / DM) + EPS);
    const f32x4* gr = (const f32x4*)gain + lane;
    v2u* o8 = (v2u*)orow + lane;
#pragma unroll
    for (int j = 0; j < 8; ++j) { const f32x4 g = gr[64 * j]; v2u w; w.x = pk2(v[j].x * r * g.x, v[j].y * r * g.y); w.y = pk2(v[j].z * r * g.z, v[j].w * r * g.w); o8[64 * j] = w; }
}
DI void cvt_f32_bf16_stream(const float* src, bf16* dst, size_t n, size_t gtid, size_t nthr) {
    for (size_t i = gtid * 8; i < n; i += nthr * 8) { const f32x4 a = *(const f32x4*)(src + i), b = *(const f32x4*)(src + i + 4);
        v4u w; w.x = pk2(a.x, a.y); w.y = pk2(a.z, a.w); w.z = pk2(b.x, b.y); w.w = pk2(b.z, b.w); *(v4u*)(dst + i) = w; }
}
DI void cvt_row_fp8(const float* src, unsigned char* dst, float* inv_scale, int lane) {
    f32x4 v[8]; float m = 0.f;
#pragma unroll
    for (int j = 0; j < 2; ++j)
#pragma unroll
        for (int q = 0; q < 4; ++q) { v[j * 4 + q] = *(const f32x4*)(src + 1024 * j + 16 * lane + 4 * q); const f32x4 a = v[j * 4 + q];
            m = fmaxf(m, fmaxf(fmaxf(fabsf(a.x), fabsf(a.y)), fmaxf(fabsf(a.z), fabsf(a.w)))); }
#pragma unroll
    for (int o = 1; o < 64; o <<= 1) m = fmaxf(m, __shfl_xor(m, o));
    const float s = m > 0.f ? 416.f / m : 1.f;
#pragma unroll
    for (int j = 0; j < 2; ++j) { v4u w;
        { const f32x4 a = v[j * 4 + 0] * s; unsigned t = __builtin_amdgcn_cvt_pk_fp8_f32(a.x, a.y, 0, false); w.x = __builtin_amdgcn_cvt_pk_fp8_f32(a.z, a.w, t, true); }
        { const f32x4 a = v[j * 4 + 1] * s; unsigned t = __builtin_amdgcn_cvt_pk_fp8_f32(a.x, a.y, 0, false); w.y = __builtin_amdgcn_cvt_pk_fp8_f32(a.z, a.w, t, true); }
        { const f32x4 a = v[j * 4 + 2] * s; unsigned t = __builtin_amdgcn_cvt_pk_fp8_f32(a.x, a.y, 0, false); w.z = __builtin_amdgcn_cvt_pk_fp8_f32(a.z, a.w, t, true); }
        { const f32x4 a = v[j * 4 + 3] * s; unsigned t = __builtin_amdgcn_cvt_pk_fp8_f32(a.x, a.y, 0, false); w.w = __builtin_amdgcn_cvt_pk_fp8_f32(a.z, a.w, t, true); }
        *(v4u*)(dst + 1024 * j + 16 * lane) = w; }
    if (lane == 0) *inv_scale = m > 0.f ? m * (1.f / 416.f) : 1.f;
}
DI void phase_prologue(const Frame& F, const Args& A) {
    LAS float* scr = (LAS float*)(F.lds + F.wave * 16384);
    const int gw = F.vcu * NWAVES + F.wave, NGW = F.G * NWAVES;
    unsigned char* ws = A.ws;
    constexpr int NB_IN = 11296 / 32;
    constexpr int I_IN = (DM / 64) * NB_IN, I_OUT = (4096 / 64) * (DM / 32), I_SQ = (DM / 64) * (DM / 32);
    constexpr int NITEMS = I_IN + I_OUT + 5 * I_SQ;
    for (int it = gw; it < NITEMS; it += NGW) {
        int r = it;
        if (r < I_IN) { const int kb = r / NB_IN, nb = r % NB_IN, n0 = 32 * nb; p0_transpose_item(A.in[I_WIN], 11296, DM, (bf16*)(ws + WS_WIN), 64 * kb, n0, n0 < 5152 ? n0 : n0 + 224, scr, F.lane); continue; } r -= I_IN;
        if (r < I_OUT) { const int kb = r / 64, nb = r % 64; p0_transpose_item(A.in[I_WOUT], DM, 4096, (bf16*)(ws + WS_WOUT), 64 * kb, 32 * nb, 32 * nb, scr, F.lane); continue; } r -= I_OUT;
        const int which = r / I_SQ; r -= which * I_SQ; const int kb = r / 64, nb = r % 64;
        const float* W = which == 0 ? A.in[I_WMQ] : which == 1 ? A.in[I_WMK] : which == 2 ? A.in[I_WMV] : which == 3 ? A.in[I_WMO] : A.in[I_WPQ];
        bf16* WT = (bf16*)(ws + (which == 0 ? WS_WQ : which == 1 ? WS_WKV : which == 2 ? WS_WKV + (size_t)DM * DM * 2 : which == 3 ? WS_WO : WS_WPQ));
        p0_transpose_item(W, DM, DM, WT, 64 * kb, 32 * nb, 32 * nb, scr, F.lane);
    }
    const size_t gtid = (size_t)F.vcu * NTHR + F.tid, nthr = (size_t)F.G * NTHR;
    { v4u z = {0u, 0u, 0u, 0u}; v4u* p = (v4u*)(ws + WS_WIN + (size_t)5152 * DM * 2); const size_t n16 = (size_t)224 * DM * 2 / 16; for (size_t i = gtid; i < n16; i += nthr) p[i] = z; }
    for (int rr = gw; rr < 2 * NEXP; rr += NGW) { const bool isv = rr >= NEXP; const int row = isv ? rr - NEXP : rr;
        cvt_row_fp8((isv ? A.in[I_V] : A.in[I_U]) + (size_t)row * DM, ws + (isv ? WS_V : WS_U) + (size_t)row * DM, (float*)(ws + (isv ? WS_VSC : WS_USC)) + row, F.lane); }
    cvt_f32_bf16_stream(A.in[I_SK], (bf16*)(ws + WS_SK), (size_t)8 * 2 * 128 * 128, gtid, nthr);
    for (int m = gw; m < NTOK + 1024; m += NGW) {
        if (m < TPR) rms_row_to_bf16(A.in[I_XP] + (size_t)m * DM, A.in[I_NMIX], (bf16*)(ws + WS_XN) + (size_t)m * DM, F.lane);
        else if (m < NTOK) rms_row_to_bf16(A.in[I_XS] + (size_t)(m - TPR) * DM, A.in[I_NMIX], (bf16*)(ws + WS_XN) + (size_t)m * DM, F.lane);
        else rms_row_to_bf16(A.in[I_MEM] + (size_t)(m - NTOK) * DM, A.in[I_NMKV], (bf16*)(ws + WS_MN) + (size_t)(m - NTOK) * DM, F.lane);
    }
}

DI void conv8(const bf16* H, size_t row0, int t, int ch0, const float* cw, const float* cb, const float* hist, float (&o)[8]) {
    { const f32x4 b0 = *(const f32x4*)(cb + ch0), b1 = *(const f32x4*)(cb + ch0 + 4); o[0] = b0.x; o[1] = b0.y; o[2] = b0.z; o[3] = b0.w; o[4] = b1.x; o[5] = b1.y; o[6] = b1.z; o[7] = b1.w; }
#pragma unroll
    for (int j = 0; j < 4; ++j) { const int tt = t - 3 + j;
        const f32x4 w0 = *(const f32x4*)(cw + j * CONVD + ch0), w1 = *(const f32x4*)(cw + j * CONVD + ch0 + 4);
        if (tt >= 0) { const v4u h = *(const v4u*)(H + (row0 + tt) * NIN + C_XBC + ch0);
            o[0] += bflo(h.x) * w0.x; o[1] += bfhi(h.x) * w0.y; o[2] += bflo(h.y) * w0.z; o[3] += bfhi(h.y) * w0.w;
            o[4] += bflo(h.z) * w1.x; o[5] += bfhi(h.z) * w1.y; o[6] += bflo(h.w) * w1.z; o[7] += bfhi(h.w) * w1.w; }
        else if (hist) { const f32x4 h0 = *(const f32x4*)(hist + (3 + tt) * CONVD + ch0), h1 = *(const f32x4*)(hist + (3 + tt) * CONVD + ch0 + 4);
            o[0] += h0.x * w0.x; o[1] += h0.y * w0.y; o[2] += h0.z * w0.z; o[3] += h0.w * w0.w; o[4] += h1.x * w1.x; o[5] += h1.y * w1.y; o[6] += h1.z * w1.z; o[7] += h1.w * w1.w; } }
#pragma unroll
    for (int e = 0; e < 8; ++e) o[e] = silu_f(o[e]);
}
constexpr int LDK = 136;

DI void ssd_pass1_item(const Frame& F, const Args& A, int item) {
    const int g = item & 3, c = (item >> 2) & 15, b = item >> 6;
    const size_t row0 = (size_t)b * SEQ + c * 128, seq0 = (size_t)b * SEQ;
    const bf16* H = (const bf16*)(A.ws + WS_H);
    LAS bf16* BT = (LAS bf16*)(F.lds);
    LAS bf16* XT = (LAS bf16*)(F.lds + 34816);
    LAS float* WSC = (LAS float*)(F.lds + 34816 + 17408);
    float* DTB = (float*)(A.ws + WS_DTB); float* ACS = (float*)(A.ws + WS_ACS);
    const int lane = F.lane, w = F.wave, tid = F.tid, fr = lane & 15, fq = lane >> 4;
    __syncthreads();
    {
        const int h = g * 8 + w; const float Ah = -__expf(A.in[I_ALOG][h]), bias = A.in[I_DTB][h];
        const float dt0 = softplus_f(bf2f(H[(row0 + lane) * NIN + C_DT + h]) + bias), dt1 = softplus_f(bf2f(H[(row0 + lane + 64) * NIN + C_DT + h]) + bias);
        float v0 = dt0 * Ah, v1 = dt1 * Ah;
#pragma unroll
        for (int o = 1; o < 64; o <<= 1) { const float t0 = __shfl_up(v0, o), t1 = __shfl_up(v1, o); if (lane >= o) { v0 += t0; v1 += t1; } }
        v1 += __shfl(v0, 63);
        const float last = __shfl(v1, 63);
        DTB[(row0 + lane) * 32 + h] = dt0; DTB[(row0 + lane + 64) * 32 + h] = dt1;
        ACS[(row0 + lane) * 32 + h] = v0; ACS[(row0 + lane + 64) * 32 + h] = v1;
        WSC[w * 128 + lane] = dt0 * __expf(last - v0); WSC[w * 128 + lane + 64] = dt1 * __expf(last - v1);
    }
#pragma unroll 1
    for (int i = 0; i < 4; ++i) { const int task = tid + 512 * i, s = task >> 4, nc = task & 15; float o[8];
        conv8(H, seq0, c * 128 + s, 2048 + g * 128 + nc * 8, A.in[I_CW], A.in[I_CB], nullptr, o);
#pragma unroll
        for (int e = 0; e < 8; ++e) BT[(nc * 8 + e) * LDK + s] = (bf16)f2bf(o[e]); }
    __syncthreads();
    bf16x8 bfr[4];
#pragma unroll
    for (int ks = 0; ks < 4; ++ks) bfr[ks] = *(const LAS bf16x8*)(BT + (16 * w + fr) * LDK + 32 * ks + 8 * fq);
    float* SLOC = (float*)(A.ws + WS_SLOC);
#pragma unroll 1
    for (int r = 0; r < 8; ++r) {
        const int h = g * 8 + r;
        if (r) __syncthreads();
#pragma unroll 1
        for (int i = 0; i < 2; ++i) { const int task = tid + 512 * i, s = task >> 3, pc = task & 7; float o[8];
            conv8(H, seq0, c * 128 + s, h * 64 + pc * 8, A.in[I_CW], A.in[I_CB], nullptr, o);
            const float sc = WSC[r * 128 + s];
#pragma unroll
            for (int e = 0; e < 8; ++e) XT[(pc * 8 + e) * LDK + s] = (bf16)f2bf(o[e] * sc); }
        __syncthreads();
        f32x4 acc[4];
#pragma unroll
        for (int pb = 0; pb < 4; ++pb) { acc[pb] = (f32x4){0.f, 0.f, 0.f, 0.f};
#pragma unroll
            for (int ks = 0; ks < 4; ++ks) { const bf16x8 a = *(const LAS bf16x8*)(XT + (16 * pb + fr) * LDK + 32 * ks + 8 * fq); acc[pb] = MFMA16(a, bfr[ks], acc[pb]); } }
        float* sl = SLOC + ((((size_t)b * 16 + c) * 32 + h) * 64) * 128;
#pragma unroll
        for (int pb = 0; pb < 4; ++pb)
#pragma unroll
            for (int j = 0; j < 4; ++j) sl[(16 * pb + 4 * fq + j) * 128 + 16 * w + fr] = acc[pb][j];
    }
}

DI void ssd_sample_item(const Frame& F, const Args& A, int item) {
    const int g = item & 3, b = item >> 2;
    const size_t row0 = (size_t)TPR + (size_t)b * LSM;
    const bf16* H = (const bf16*)(A.ws + WS_H);
    LAS float* XS = (LAS float*)(F.lds);
    LAS float* BS = (LAS float*)(F.lds + 16384);
    LAS float* CS = (LAS float*)(F.lds + 20480);
    LAS float* YO = (LAS float*)(F.lds + 24576);
    const int lane = F.lane, w = F.wave, tid = F.tid;
    __syncthreads();
    const float* hist = A.in[I_SCONV] + (size_t)b * 3 * CONVD;
#pragma unroll 1
    for (int task = tid; task < 8 * 96; task += NTHR) { const int t = task / 96, cc = task % 96; float o[8];
        const int ch0 = cc < 64 ? g * 512 + cc * 8 : (cc < 80 ? 2048 + g * 128 + (cc - 64) * 8 : 2560 + g * 128 + (cc - 80) * 8);
        conv8(H, row0, t, ch0, A.in[I_CW], A.in[I_CB], hist, o);
        LAS float* dst = cc < 64 ? XS + t * 512 + cc * 8 : (cc < 80 ? BS + t * 128 + (cc - 64) * 8 : CS + t * 128 + (cc - 80) * 8);
#pragma unroll
        for (int e = 0; e < 8; ++e) dst[e] = o[e]; }
    __syncthreads();
    const int h = g * 8 + w, pl = lane >> 4, nl = lane & 15;
    const float Ah = -__expf(A.in[I_ALOG][h]), bias = A.in[I_DTB][h], Dh = A.in[I_D][h];
    float st[16][8];
    const float* sp = A.in[I_SSM] + (((size_t)b * 32 + h) * 64 + 16 * pl) * 128 + 8 * nl;
#pragma unroll
    for (int i = 0; i < 16; ++i) { const f32x4 a0 = *(const f32x4*)(sp + i * 128), a1 = *(const f32x4*)(sp + i * 128 + 4);
        st[i][0] = a0.x; st[i][1] = a0.y; st[i][2] = a0.z; st[i][3] = a0.w; st[i][4] = a1.x; st[i][5] = a1.y; st[i][6] = a1.z; st[i][7] = a1.w; }
#pragma unroll 1
    for (int t = 0; t < 8; ++t) {
        const float dt = softplus_f(bf2f(H[(row0 + t) * NIN + C_DT + h]) + bias), da = __expf(dt * Ah);
        float bv[8], cv[8];
#pragma unroll
        for (int k = 0; k < 8; ++k) { bv[k] = BS[t * 128 + 8 * nl + k]; cv[k] = CS[t * 128 + 8 * nl + k]; }
        float mine = 0.f;
#pragma unroll
        for (int i = 0; i < 16; ++i) { const float xd = dt * XS[t * 512 + w * 64 + 16 * pl + i]; float yp = 0.f;
#pragma unroll
            for (int k = 0; k < 8; ++k) { st[i][k] = st[i][k] * da + xd * bv[k]; yp += st[i][k] * cv[k]; }
            yp += __shfl_xor(yp, 1); yp += __shfl_xor(yp, 2); yp += __shfl_xor(yp, 4); yp += __shfl_xor(yp, 8);
            mine = (nl == i) ? yp : mine; }
        const int p = 16 * pl + nl;
        const float xv = XS[t * 512 + w * 64 + p], z = bf2f(H[(row0 + t) * NIN + C_Z + h * 64 + p]);
        YO[t * 512 + w * 64 + p] = (mine + Dh * xv) * silu_f(z);
    }
    float* so = A.out + O_SSSM + (((size_t)b * 32 + h) * 64 + 16 * pl) * 128 + 8 * nl;
#pragma unroll
    for (int i = 0; i < 16; ++i) { *(f32x4*)(so + i * 128) = (f32x4){st[i][0], st[i][1], st[i][2], st[i][3]}; *(f32x4*)(so + i * 128 + 4) = (f32x4){st[i][4], st[i][5], st[i][6], st[i][7]}; }
    __syncthreads();
    {
        float v[8]; float ss = 0.f;
#pragma unroll
        for (int k = 0; k < 8; ++k) { v[k] = YO[w * 512 + lane + 64 * k]; ss += v[k] * v[k]; }
        const float r = rsqrtf(wave_sum(ss) * (1.f / 512.f) + EPS);
        bf16* ym = (bf16*)(A.ws + WS_YM) + (row0 + w) * 4096 + g * 512;
#pragma unroll
        for (int k = 0; k < 8; ++k) ym[lane + 64 * k] = (bf16)f2bf(v[k] * r * A.in[I_SSDN][g * 512 + lane + 64 * k]);
    }
}

DI void short_conv_all(const Frame& F, const Args& A) {
    const bf16* H = (const bf16*)(A.ws + WS_H); bf16* YM = (bf16*)(A.ws + WS_YM);
    const float* scw = A.in[I_SCW];
    const size_t gtid = (size_t)F.vcu * NTHR + F.tid, nthr = (size_t)F.G * NTHR;
    for (size_t task = gtid; task < (size_t)NTOK * 256; task += nthr) {
        const int row = (int)(task >> 8), ch0 = (int)(task & 255) * 8;
        const bool pr = row < TPR; const int b = pr ? row >> 11 : (row - TPR) >> 3, t = pr ? row & 2047 : (row - TPR) & 7, L = pr ? SEQ : LSM;
        float cv[8], ucur[8];
#pragma unroll
        for (int e = 0; e < 8; ++e) cv[e] = 0.f;
#pragma unroll
        for (int j = 0; j < 3; ++j) { const int tt = t - 2 + j; float u[8];
            if (tt >= 0) { const v4u hc = *(const v4u*)(H + (size_t)(row - t + tt) * NIN + C_SCC + ch0), hh = *(const v4u*)(H + (size_t)(row - t + tt) * NIN + C_SCH + ch0);
                u[0] = bflo(hc.x) * bflo(hh.x); u[1] = bfhi(hc.x) * bfhi(hh.x); u[2] = bflo(hc.y) * bflo(hh.y); u[3] = bfhi(hc.y) * bfhi(hh.y);
                u[4] = bflo(hc.z) * bflo(hh.z); u[5] = bfhi(hc.z) * bfhi(hh.z); u[6] = bflo(hc.w) * bflo(hh.w); u[7] = bfhi(hc.w) * bfhi(hh.w); }
            else if (!pr) { const float* hp = A.in[I_SSC] + ((size_t)b * 2 + (2 + tt)) * DM + ch0; const f32x4 a0 = *(const f32x4*)hp, a1 = *(const f32x4*)(hp + 4);
                u[0] = a0.x; u[1] = a0.y; u[2] = a0.z; u[3] = a0.w; u[4] = a1.x; u[5] = a1.y; u[6] = a1.z; u[7] = a1.w; }
            else {
#pragma unroll
                for (int e = 0; e < 8; ++e) u[e] = 0.f; }
            const f32x4 w0 = *(const f32x4*)(scw + j * DM + ch0), w1 = *(const f32x4*)(scw + j * DM + ch0 + 4);
            cv[0] += u[0] * w0.x; cv[1] += u[1] * w0.y; cv[2] += u[2] * w0.z; cv[3] += u[3] * w0.w; cv[4] += u[4] * w1.x; cv[5] += u[5] * w1.y; cv[6] += u[6] * w1.z; cv[7] += u[7] * w1.w;
            if (j == 2) {
#pragma unroll
                for (int e = 0; e < 8; ++e) ucur[e] = u[e]; } }
        const v4u hb = *(const v4u*)(H + (size_t)row * NIN + C_SCB + ch0);
        v4u o; o.x = pk2(bflo(hb.x) * cv[0], bfhi(hb.x) * cv[1]); o.y = pk2(bflo(hb.y) * cv[2], bfhi(hb.y) * cv[3]); o.z = pk2(bflo(hb.z) * cv[4], bfhi(hb.z) * cv[5]); o.w = pk2(bflo(hb.w) * cv[6], bfhi(hb.w) * cv[7]);
        *(v4u*)(YM + (size_t)row * 4096 + 2048 + ch0) = o;
        if (t >= L - 2) { float* op = A.out + (pr ? O_PSC : O_SSC) + ((size_t)b * 2 + (t - (L - 2))) * DM + ch0;
            *(f32x4*)op = (f32x4){ucur[0], ucur[1], ucur[2], ucur[3]}; *(f32x4*)(op + 4) = (f32x4){ucur[4], ucur[5], ucur[6], ucur[7]}; }
    }
    for (size_t task = gtid; task < (size_t)(NBP + NBS) * 3 * (CONVD / 8); task += nthr) {
        const int cc = (int)(task % (CONVD / 8)), j = (int)((task / (CONVD / 8)) % 3), bb = (int)(task / (3 * (CONVD / 8)));
        const bool pr = bb < NBP; const int b = pr ? bb : bb - NBP;
        const size_t row = pr ? (size_t)b * SEQ + (SEQ - 3 + j) : (size_t)TPR + (size_t)b * LSM + (LSM - 3 + j);
        const v4u h = *(const v4u*)(H + row * NIN + C_XBC + cc * 8);
        float* op = A.out + (pr ? O_PCONV : O_SCONV) + ((size_t)b * 3 + j) * CONVD + cc * 8;
        *(f32x4*)op = (f32x4){bflo(h.x), bfhi(h.x), bflo(h.y), bfhi(h.y)}; *(f32x4*)(op + 4) = (f32x4){bflo(h.z), bfhi(h.z), bflo(h.w), bfhi(h.w)};
    }
}

DI void ssd_propagate(const Frame& F, const Args& A) {
    const float* SLOC = (const float*)(A.ws + WS_SLOC); bf16* SIN = (bf16*)(A.ws + WS_SIN); const float* ACS = (const float*)(A.ws + WS_ACS);
    const size_t gtid = (size_t)F.vcu * NTHR + F.tid, nthr = (size_t)F.G * NTHR;
    for (size_t idx = gtid; idx < (size_t)4 * 32 * 64 * 32; idx += nthr) {
        const int n4 = (int)(idx & 31), p = (int)((idx >> 5) & 63), h = (int)((idx >> 11) & 31), b = (int)(idx >> 16);
        f32x4 S = {0.f, 0.f, 0.f, 0.f};
#pragma unroll 4
        for (int c = 0; c < 16; ++c) {
            const size_t off = ((((size_t)b * 16 + c) * 32 + h) * 64 + p) * 128 + n4 * 4;
            v2u w; w.x = pk2(S.x, S.y); w.y = pk2(S.z, S.w); *(v2u*)(SIN + off) = w;
            const float dec = __expf(ACS[((size_t)b * SEQ + c * 128 + 127) * 32 + h]);
            const f32x4 l = *(const f32x4*)(SLOC + off);
            S = S * dec + l;
        }
        *(f32x4*)(A.out + O_PSSM + (((size_t)b * 32 + h) * 64 + p) * 128 + n4 * 4) = S;
    }
}

DI void ssd_pass2_item(const Frame& F, const Args& A, int item) {
    const int g = item & 3, c = (item >> 2) & 15, b = item >> 6;
    const size_t row0 = (size_t)b * SEQ + c * 128, seq0 = (size_t)b * SEQ;
    const bf16* H = (const bf16*)(A.ws + WS_H);
    LAS bf16* Bn = (LAS bf16*)(F.lds);
    LAS bf16* Cn = (LAS bf16*)(F.lds + 34816);
    LAS bf16* XT = (LAS bf16*)(F.lds + 69632);
    LAS bf16* XR = (LAS bf16*)(F.lds + 87040);
    LAS bf16* Mw = (LAS bf16*)(F.lds + 104448);
    LAS float* ACSL = (LAS float*)(F.lds + 139264);
    LAS float* DTL = (LAS float*)(F.lds + 143360);
    const int lane = F.lane, w = F.wave, tid = F.tid, fr = lane & 15, fq = lane >> 4;
    __syncthreads();
    { const float* DTB = (const float*)(A.ws + WS_DTB); const float* ACS = (const float*)(A.ws + WS_ACS);
#pragma unroll
      for (int i = 0; i < 2; ++i) { const int e = tid + 512 * i, s = e >> 3, r = e & 7; ACSL[r * 128 + s] = ACS[(row0 + s) * 32 + g * 8 + r]; DTL[r * 128 + s] = DTB[(row0 + s) * 32 + g * 8 + r]; } }
#pragma unroll 1
    for (int i = 0; i < 8; ++i) { const int task = tid + 512 * i, s = task >> 5, cc = task & 31; float o[8];
        const int ch0 = cc < 16 ? 2048 + g * 128 + cc * 8 : 2560 + g * 128 + (cc - 16) * 8;
        conv8(H, seq0, c * 128 + s, ch0, A.in[I_CW], A.in[I_CB], nullptr, o);
        v4u pk; pk.x = pk2(o[0], o[1]); pk.y = pk2(o[2], o[3]); pk.z = pk2(o[4], o[5]); pk.w = pk2(o[6], o[7]);
        *(LAS v4u*)((cc < 16 ? Bn + s * LDK + cc * 8 : Cn + s * LDK + (cc - 16) * 8)) = pk; }
    __syncthreads();
    f32x4 cb[8];
    {   bf16x8 cf[4];
#pragma unroll
        for (int ks = 0; ks < 4; ++ks) cf[ks] = *(const LAS bf16x8*)(Cn + (16 * w + fr) * LDK + 32 * ks + 8 * fq);
#pragma unroll
        for (int sb = 0; sb < 8; ++sb) { cb[sb] = (f32x4){0.f, 0.f, 0.f, 0.f};
#pragma unroll
            for (int ks = 0; ks < 4; ++ks) { const bf16x8 bf = *(const LAS bf16x8*)(Bn + (16 * sb + fr) * LDK + 32 * ks + 8 * fq); cb[sb] = MFMA16(cf[ks], bf, cb[sb]); } } }
    float ssq[4] = {0.f, 0.f, 0.f, 0.f};
    const bf16* SIN = (const bf16*)(A.ws + WS_SIN);
    bf16* YM = (bf16*)(A.ws + WS_YM);
#pragma unroll 1
    for (int r = 0; r < 8; ++r) {
        const int h = g * 8 + r;
        if (r) __syncthreads();
#pragma unroll 1
        for (int i = 0; i < 2; ++i) { const int task = tid + 512 * i, s = task >> 3, pc = task & 7; float o[8];
            conv8(H, seq0, c * 128 + s, h * 64 + pc * 8, A.in[I_CW], A.in[I_CB], nullptr, o);
            const float dt = DTL[r * 128 + s];
#pragma unroll
            for (int e = 0; e < 8; ++e) { XR[(pc * 8 + e) * LDK + s] = (bf16)f2bf(o[e]); XT[(pc * 8 + e) * LDK + s] = (bf16)f2bf(o[e] * dt); } }
        {   float al[4];
#pragma unroll
            for (int j = 0; j < 4; ++j) al[j] = ACSL[r * 128 + 16 * w + 4 * fq + j];
#pragma unroll
            for (int sb = 0; sb < 8; ++sb) { const int s = 16 * sb + fr; const float as = ACSL[r * 128 + s];
#pragma unroll
                for (int j = 0; j < 4; ++j) { const int l = 16 * w + 4 * fq + j; const float v = (s <= l) ? cb[sb][j] * __expf(al[j] - as) : 0.f;
                    Mw[(w * 16 + 4 * fq + j) * LDK + s] = (bf16)f2bf(v); } } }
        __syncthreads();
        f32x4 acc[4];
        {
            const bf16* sin = SIN + ((((size_t)b * 16 + c) * 32 + h) * 64) * 128;
#pragma unroll
            for (int pb = 0; pb < 4; ++pb) acc[pb] = (f32x4){0.f, 0.f, 0.f, 0.f};
#pragma unroll
            for (int ks = 0; ks < 4; ++ks) { const bf16x8 a = *(const LAS bf16x8*)(Cn + (16 * w + fr) * LDK + 32 * ks + 8 * fq);
#pragma unroll
                for (int pb = 0; pb < 4; ++pb) { const bf16x8 bf = *(const bf16x8*)(sin + (16 * pb + fr) * 128 + 32 * ks + 8 * fq); acc[pb] = MFMA16(a, bf, acc[pb]); } }
#pragma unroll
            for (int j = 0; j < 4; ++j) { const float e = __expf(ACSL[r * 128 + 16 * w + 4 * fq + j]);
#pragma unroll
                for (int pb = 0; pb < 4; ++pb) acc[pb][j] *= e; }
        }
#pragma unroll
        for (int ks = 0; ks < 4; ++ks) if (32 * ks < 16 * (w + 1)) { const bf16x8 a = *(const LAS bf16x8*)(Mw + (w * 16 + fr) * LDK + 32 * ks + 8 * fq);
#pragma unroll
            for (int pb = 0; pb < 4; ++pb) { const bf16x8 bf = *(const LAS bf16x8*)(XT + (16 * pb + fr) * LDK + 32 * ks + 8 * fq); acc[pb] = MFMA16(a, bf, acc[pb]); } }
        const float Dh = A.in[I_D][h];
#pragma unroll
        for (int pb = 0; pb < 4; ++pb)
#pragma unroll
            for (int j = 0; j < 4; ++j) { const int l = 16 * w + 4 * fq + j, p = 16 * pb + fr;
                const float z = bf2f(H[(row0 + l) * NIN + C_Z + h * 64 + p]);
                const float y = (acc[pb][j] + Dh * bf2f(XR[p * LDK + l])) * silu_f(z);
                ssq[j] += y * y; YM[(row0 + l) * 4096 + h * 64 + p] = (bf16)f2bf(y); }
    }
    float rstd[4];
#pragma unroll
    for (int j = 0; j < 4; ++j) { float s = ssq[j]; s += __shfl_xor(s, 1); s += __shfl_xor(s, 2); s += __shfl_xor(s, 4); s += __shfl_xor(s, 8); rstd[j] = rsqrtf(s * (1.f / 512.f) + EPS); }
    asm volatile("s_waitcnt vmcnt(0)" ::: "memory");
#pragma unroll 1
    for (int r = 0; r < 8; ++r)
#pragma unroll
        for (int pb = 0; pb < 4; ++pb) { const int col = (g * 8 + r) * 64 + 16 * pb + fr; const float gn = A.in[I_SSDN][col];
#pragma unroll
            for (int j = 0; j < 4; ++j) { bf16* yp = YM + (row0 + 16 * w + 4 * fq + j) * 4096 + col; *yp = (bf16)f2bf(bf2f(*(volatile bf16*)yp) * rstd[j] * gn); } }
}

DI void phase_norm_rows(const Frame& F, const Args& A, const float* gain) {
    const int gw = F.vcu * NWAVES + F.wave, NGW = F.G * NWAVES;
    for (int m = gw; m < NTOK; m += NGW) rms_row_to_bf16((const float*)(A.ws + WS_X1) + (size_t)m * DM, gain, (bf16*)(A.ws + WS_XN) + (size_t)m * DM, F.lane);
}

constexpr int LDP = 264;
DI void attn_prompt_unit(const Frame& F, const Args& A, int unit) {
    const int qb = unit & 15, h = (unit >> 4) & 3, b = unit >> 6;
    const int lane = F.lane, w = F.wave, fr = lane & 15, fq = lane >> 4;
    const bf16* QB = (const bf16*)(A.ws + WS_QB); const bf16* KP = (const bf16*)(A.ws + WS_KP); const bf16* VPT = (const bf16*)(A.ws + WS_VPT); bf16* OB = (bf16*)(A.ws + WS_OB);
    LAS bf16* Pw = (LAS bf16*)(F.lds) + w * 16 * LDP;
    const size_t qrow0 = (size_t)b * SEQ + qb * 128 + 16 * w;
    __syncthreads();
    f32x4 s[16];
#pragma unroll
    for (int kb = 0; kb < 16; ++kb) s[kb] = (f32x4){0.f, 0.f, 0.f, 0.f};
    const bf16* qp = QB + (qrow0 + fr) * DM + h * 512 + 8 * fq;
    const bf16* kp = KP + ((size_t)b * 256 + fr) * DM + h * 512 + 8 * fq;
#pragma unroll 2
    for (int ks = 0; ks < 16; ++ks) { const bf16x8 a = *(const bf16x8*)(qp + 32 * ks);
#pragma unroll
        for (int kb = 0; kb < 16; ++kb) { const bf16x8 bf = *(const bf16x8*)(kp + (size_t)(16 * kb) * DM + 32 * ks); s[kb] = MFMA16(a, bf, s[kb]); } }
    const float scale = 0.044194173824159216f;
    float mx[4], sm[4];
#pragma unroll
    for (int j = 0; j < 4; ++j) { float m = s[0][j];
#pragma unroll
        for (int kb = 1; kb < 16; ++kb) m = fmaxf(m, s[kb][j]);
        m = fmaxf(m, __shfl_xor(m, 1)); m = fmaxf(m, __shfl_xor(m, 2)); m = fmaxf(m, __shfl_xor(m, 4)); m = fmaxf(m, __shfl_xor(m, 8)); mx[j] = m; sm[j] = 0.f; }
#pragma unroll
    for (int kb = 0; kb < 16; ++kb)
#pragma unroll
        for (int j = 0; j < 4; ++j) { const float p = __expf((s[kb][j] - mx[j]) * scale); sm[j] += p; Pw[(4 * fq + j) * LDP + 16 * kb + fr] = (bf16)f2bf(p); }
#pragma unroll
    for (int j = 0; j < 4; ++j) { float t = sm[j]; t += __shfl_xor(t, 1); t += __shfl_xor(t, 2); t += __shfl_xor(t, 4); t += __shfl_xor(t, 8); sm[j] = 1.f / t; }
    __syncthreads();
    const bf16* vp = VPT + ((size_t)b * 2048 + h * 512 + fr) * 256 + 8 * fq;
#pragma unroll 1
    for (int dg = 0; dg < 4; ++dg) {
        f32x4 o[8];
#pragma unroll
        for (int db = 0; db < 8; ++db) o[db] = (f32x4){0.f, 0.f, 0.f, 0.f};
#pragma unroll 2
        for (int ks = 0; ks < 8; ++ks) { const bf16x8 a = *(const LAS bf16x8*)(Pw + fr * LDP + 32 * ks + 8 * fq);
#pragma unroll
            for (int db = 0; db < 8; ++db) { const bf16x8 bf = *(const bf16x8*)(vp + (size_t)(dg * 128 + 16 * db) * 256 + 32 * ks); o[db] = MFMA16(a, bf, o[db]); } }
#pragma unroll
        for (int db = 0; db < 8; ++db)
#pragma unroll
            for (int j = 0; j < 4; ++j) OB[(qrow0 + 4 * fq + j) * DM + h * 512 + dg * 128 + 16 * db + fr] = (bf16)f2bf(o[db][j] * sm[j]);
    }
}
DI void attn_sample_unit(const Frame& F, const Args& A, int unit) {
    const int h = unit & 3, b = unit >> 2;
    const int lane = F.lane, w = F.wave, tid = F.tid;
    LAS float* QS = (LAS float*)(F.lds);
    LAS float* RED = (LAS float*)(F.lds + 16384);
    LAS float* P = (LAS float*)(F.lds + 16384 + 65536);
    const bf16* QB = (const bf16*)(A.ws + WS_QB); bf16* OB = (bf16*)(A.ws + WS_OB);
    const size_t row0 = (size_t)TPR + (size_t)b * LSM;
    __syncthreads();
    const float scale = 0.044194173824159216f;
    for (int e = tid; e < 8 * 512; e += NTHR) QS[e] = bf2f(QB[(row0 + (e >> 9)) * DM + h * 512 + (e & 511)]) * scale;
    __syncthreads();
    const float* CK = A.in[I_CK] + ((size_t)b * 256 * 4 + h) * 512 + 64 * w;
#pragma unroll 1
    for (int kg = 0; kg < 4; ++kg) { const int m = lane + 64 * kg; const float* kp = CK + (size_t)m * 2048;
        float acc[8];
#pragma unroll
        for (int t = 0; t < 8; ++t) acc[t] = 0.f;
#pragma unroll 4
        for (int dd = 0; dd < 16; ++dd) { const f32x4 kv = *(const f32x4*)(kp + 4 * dd);
#pragma unroll
            for (int t = 0; t < 8; ++t) { const f32x4 q = *(const LAS f32x4*)(QS + t * 512 + 64 * w + 4 * dd); acc[t] += kv.x * q.x + kv.y * q.y + kv.z * q.z + kv.w * q.w; } }
#pragma unroll
        for (int t = 0; t < 8; ++t) RED[(w * 8 + t) * 256 + m] = acc[t]; }
    __syncthreads();
    {
        float v[4]; float mx = -3.0e38f;
#pragma unroll
        for (int i = 0; i < 4; ++i) { float s = 0.f;
#pragma unroll
            for (int ww = 0; ww < 8; ++ww) s += RED[(ww * 8 + w) * 256 + lane + 64 * i];
            v[i] = s; mx = fmaxf(mx, s); }
#pragma unroll
        for (int o = 1; o < 64; o <<= 1) mx = fmaxf(mx, __shfl_xor(mx, o));
        float sum = 0.f;
#pragma unroll
        for (int i = 0; i < 4; ++i) { v[i] = __expf(v[i] - mx); sum += v[i]; }
        const float inv = 1.f / wave_sum(sum);
#pragma unroll
        for (int i = 0; i < 4; ++i) P[(lane + 64 * i) * 8 + w] = v[i] * inv;
    }
    __syncthreads();
    {   const float* CV = A.in[I_CV] + ((size_t)b * 256 * 4 + h) * 512 + 64 * w + lane;
        float acc[8];
#pragma unroll
        for (int t = 0; t < 8; ++t) acc[t] = 0.f;
#pragma unroll 8
        for (int m = 0; m < 256; ++m) { const float v = CV[(size_t)m * 2048]; const f32x4 p0 = *(const LAS f32x4*)(P + m * 8), p1 = *(const LAS f32x4*)(P + m * 8 + 4);
            acc[0] += p0.x * v; acc[1] += p0.y * v; acc[2] += p0.z * v; acc[3] += p0.w * v; acc[4] += p1.x * v; acc[5] += p1.y * v; acc[6] += p1.z * v; acc[7] += p1.w * v; }
#pragma unroll
        for (int t = 0; t < 8; ++t) OB[(row0 + t) * DM + h * 512 + 64 * w + lane] = (bf16)f2bf(acc[t]);
    }
}

DI unsigned ord_f(float f) { const unsigned u = __builtin_bit_cast(unsigned, f); return (u & 0x80000000u) ? ~u : (u | 0x80000000u); }
DI float unord_f(unsigned k) { const unsigned u = (k & 0x80000000u) ? (k ^ 0x80000000u) : ~k; return __builtin_bit_cast(float, u); }
DI void peer_topk_unit(const Args& A, int unit, int lane) {
    const int h = unit & 7, tok0 = (unit >> 3) * 16, fr = lane & 15, fq = lane >> 4;
    const bf16* PQ = (const bf16*)(A.ws + WS_QB); const bf16* SK = (const bf16*)(A.ws + WS_SK);
    unsigned my1[4], top2[16];
#pragma unroll
    for (int i = 0; i < 2; ++i) {
        f32x4 acc[8];
#pragma unroll
        for (int kb = 0; kb < 8; ++kb) acc[kb] = (f32x4){0.f, 0.f, 0.f, 0.f};
#pragma unroll 1
        for (int ks = 0; ks < 4; ++ks) { const bf16x8 bt = *(const bf16x8*)(PQ + (size_t)(tok0 + fr) * DM + h * 256 + i * 128 + 32 * ks + 8 * fq);
#pragma unroll
            for (int kb = 0; kb < 8; ++kb) { const bf16x8 ak = *(const bf16x8*)(SK + ((size_t)(h * 2 + i) * 128 + 16 * kb + fr) * 128 + 32 * ks + 8 * fq); acc[kb] = MFMA16(ak, bt, acc[kb]); } }
        unsigned pk[32];
#pragma unroll
        for (int kb = 0; kb < 8; ++kb)
#pragma unroll
            for (int j = 0; j < 4; ++j) pk[kb * 4 + j] = (ord_f(acc[kb][j]) & ~127u) | (unsigned)(127 - (16 * kb + 4 * fq + j));
        unsigned prev = 0xFFFFFFFFu;
#pragma unroll
        for (int r = 0; r < 16; ++r) { unsigned loc = 0u;
#pragma unroll
            for (int e = 0; e < 32; ++e) { const unsigned cnd = pk[e] < prev ? pk[e] : 0u; loc = loc > cnd ? loc : cnd; }
            unsigned o = (unsigned)__shfl_xor((int)loc, 16); loc = loc > o ? loc : o; o = (unsigned)__shfl_xor((int)loc, 32); loc = loc > o ? loc : o;
            prev = loc;
            if (i == 0) { if ((r & 3) == 0) my1[r >> 2] = loc; else my1[r >> 2] = (fq == (r & 3)) ? loc : my1[r >> 2]; }
            else top2[r] = loc; }
    }
    float s1[4], s2[16];
#pragma unroll
    for (int sl = 0; sl < 4; ++sl) s1[sl] = unord_f(my1[sl] & ~127u);
#pragma unroll
    for (int bb = 0; bb < 16; ++bb) s2[bb] = unord_f(top2[bb] & ~127u);
    float cs[21]; unsigned ck[21];
#pragma unroll
    for (int ci = 0; ci < 21; ++ci) { const int sl = ci < 16 ? 0 : (ci < 19 ? 1 : (ci < 20 ? 2 : 3)), bb = ci < 16 ? ci : (ci < 19 ? ci - 16 : 0);
        cs[ci] = s1[sl] + s2[bb]; ck[ci] = (ord_f(cs[ci]) & ~127u) | (unsigned)(127 - (fq * 21 + ci)); }
    unsigned prev = 0xFFFFFFFFu, first = 0u;
#pragma unroll
    for (int r = 0; r < 16; ++r) { unsigned loc = 0u;
#pragma unroll
        for (int ci = 0; ci < 21; ++ci) { const unsigned cnd = ck[ci] < prev ? ck[ci] : 0u; loc = loc > cnd ? loc : cnd; }
        unsigned o = (unsigned)__shfl_xor((int)loc, 16); loc = loc > o ? loc : o; o = (unsigned)__shfl_xor((int)loc, 32); loc = loc > o ? loc : o;
        prev = loc; if (r == 0) first = loc; }
    const float mx = unord_f(first & ~127u);
    float ev[21]; float esum = 0.f; int cnt = 0;
#pragma unroll
    for (int ci = 0; ci < 21; ++ci) { const bool sel = ck[ci] >= prev; ev[ci] = sel ? __expf(cs[ci] - mx) : 0.f; esum += ev[ci]; cnt += sel ? 1 : 0; }
    esum += __shfl_xor(esum, 16); esum += __shfl_xor(esum, 32);
    const float inv = 1.f / esum;
    const int c0 = __shfl(cnt, fr), c1 = __shfl(cnt, fr + 16), c2 = __shfl(cnt, fr + 32);
    int pos = (fq > 0 ? c0 : 0) + (fq > 1 ? c1 : 0) + (fq > 2 ? c2 : 0);
    int* EID = (int*)(A.ws + WS_EID) + (size_t)(tok0 + fr) * 128 + h * 16; float* GATE = (float*)(A.ws + WS_GATE) + (size_t)(tok0 + fr) * 128 + h * 16;
#pragma unroll
    for (int ci = 0; ci < 21; ++ci) { const int sl = ci < 16 ? 0 : (ci < 19 ? 1 : (ci < 20 ? 2 : 3)), bb = ci < 16 ? ci : (ci < 19 ? ci - 16 : 0);
        if (ck[ci] >= prev) { const int i1 = 127 - (int)(my1[sl] & 127u), i2 = 127 - (int)(top2[bb] & 127u);
            if (pos < 16) { EID[pos] = i1 * 128 + i2; GATE[pos] = ev[ci] * inv; } ++pos; } }
}
DI float gelu_erf(float x) { return 0.5f * x * (1.0f + erff(x * 0.70710678118654752f)); }
DI f32x2 fp8x2(unsigned w, bool hi) { const unsigned w_ = w; return hi ? __builtin_amdgcn_cvt_pk_f32_fp8(w_, true) : __builtin_amdgcn_cvt_pk_f32_fp8(w_, false); }
DI float reduce8(const float (&v)[8], int lane) {
    float a[4], b[2];
#pragma unroll
    for (int i = 0; i < 4; ++i) { const bool hi = lane & 1; const float keep = hi ? v[2 * i + 1] : v[2 * i], send = hi ? v[2 * i] : v[2 * i + 1]; a[i] = keep + __shfl_xor(send, 1); }
#pragma unroll
    for (int i = 0; i < 2; ++i) { const bool hi = lane & 2; const float keep = hi ? a[2 * i + 1] : a[2 * i], send = hi ? a[2 * i] : a[2 * i + 1]; b[i] = keep + __shfl_xor(send, 2); }
    float c; { const bool hi = lane & 4; const float keep = hi ? b[1] : b[0], send = hi ? b[0] : b[1]; c = keep + __shfl_xor(send, 4); }
    c += __shfl_xor(c, 8); c += __shfl_xor(c, 16); c += __shfl_xor(c, 32);
    return c;
}
DI void peer_gather_token(const Args& A, int t, int lane) {
    const unsigned char* U8 = A.ws + WS_U; const unsigned char* V8 = A.ws + WS_V; const float* USC = (const float*)(A.ws + WS_USC); const float* VSC = (const float*)(A.ws + WS_VSC);
    f32x2 xf[16];
    { const bf16* xr = (const bf16*)(A.ws + WS_XN) + (size_t)t * DM;
#pragma unroll
      for (int j = 0; j < 2; ++j) { const v4u a = *(const v4u*)(xr + 1024 * j + 16 * lane), b = *(const v4u*)(xr + 1024 * j + 16 * lane + 8);
        xf[j * 8 + 0] = (f32x2){bflo(a.x), bfhi(a.x)}; xf[j * 8 + 1] = (f32x2){bflo(a.y), bfhi(a.y)}; xf[j * 8 + 2] = (f32x2){bflo(a.z), bfhi(a.z)}; xf[j * 8 + 3] = (f32x2){bflo(a.w), bfhi(a.w)};
        xf[j * 8 + 4] = (f32x2){bflo(b.x), bfhi(b.x)}; xf[j * 8 + 5] = (f32x2){bflo(b.y), bfhi(b.y)}; xf[j * 8 + 6] = (f32x2){bflo(b.z), bfhi(b.z)}; xf[j * 8 + 7] = (f32x2){bflo(b.w), bfhi(b.w)}; } }
    const int* EID = (const int*)(A.ws + WS_EID) + (size_t)t * 128; const float* GATE = (const float*)(A.ws + WS_GATE) + (size_t)t * 128;
    f32x2 out[16];
#pragma unroll
    for (int e = 0; e < 16; ++e) out[e] = (f32x2){0.f, 0.f};
#pragma unroll 1
    for (int half = 0; half < 2; ++half) {
        const int myeid = EID[half * 64 + lane]; const float mygate = GATE[half * 64 + lane];
        const float myusc = USC[myeid], myvsc = VSC[myeid];
        float myact = 0.f;
#pragma unroll 1
        for (int k = 0; k < 64; k += 8) {
            v4u r[8][2];
#pragma unroll
            for (int q = 0; q < 8; ++q) { const int e = __builtin_amdgcn_readlane(myeid, k + q); const unsigned char* up = U8 + (size_t)e * DM + 16 * lane; r[q][0] = *(const v4u*)up; r[q][1] = *(const v4u*)(up + 1024); }
            float d[8];
#pragma unroll
            for (int q = 0; q < 8; ++q) { f32x2 a2 = {0.f, 0.f};
#pragma unroll
                for (int j = 0; j < 2; ++j) { const v4u w = r[q][j];
                    a2 += xf[j * 8 + 0] * fp8x2(w.x, false); a2 += xf[j * 8 + 1] * fp8x2(w.x, true); a2 += xf[j * 8 + 2] * fp8x2(w.y, false); a2 += xf[j * 8 + 3] * fp8x2(w.y, true);
                    a2 += xf[j * 8 + 4] * fp8x2(w.z, false); a2 += xf[j * 8 + 5] * fp8x2(w.z, true); a2 += xf[j * 8 + 6] * fp8x2(w.w, false); a2 += xf[j * 8 + 7] * fp8x2(w.w, true); }
                d[q] = a2.x + a2.y; }
            const float s = reduce8(d, lane);
            myact = ((lane >> 3) == (k >> 3)) ? s : myact;
        }
        const float mywgt = mygate * gelu_erf(myact * myusc) * myvsc;
#pragma unroll 1
        for (int k = 0; k < 64; k += 8) {
            v4u r[8][2];
#pragma unroll
            for (int q = 0; q < 8; ++q) { const int e = __builtin_amdgcn_readlane(myeid, k + q); const unsigned char* vp = V8 + (size_t)e * DM + 16 * lane; r[q][0] = *(const v4u*)vp; r[q][1] = *(const v4u*)(vp + 1024); }
#pragma unroll
            for (int q = 0; q < 8; ++q) { const float wg = __builtin_bit_cast(float, __builtin_amdgcn_readlane(__builtin_bit_cast(int, mywgt), k + q)); const f32x2 w2 = {wg, wg};
#pragma unroll
                for (int j = 0; j < 2; ++j) { const v4u w = r[q][j];
                    out[j * 8 + 0] += w2 * fp8x2(w.x, false); out[j * 8 + 1] += w2 * fp8x2(w.x, true); out[j * 8 + 2] += w2 * fp8x2(w.y, false); out[j * 8 + 3] += w2 * fp8x2(w.y, true);
                    out[j * 8 + 4] += w2 * fp8x2(w.z, false); out[j * 8 + 5] += w2 * fp8x2(w.z, true); out[j * 8 + 6] += w2 * fp8x2(w.w, false); out[j * 8 + 7] += w2 * fp8x2(w.w, true); } }
        }
    }
    const float* x2 = (const float*)(A.ws + WS_X1) + (size_t)t * DM; float ss = 0.f;
#pragma unroll
    for (int j = 0; j < 2; ++j)
#pragma unroll
        for (int q = 0; q < 4; ++q) { const f32x4 a = *(const f32x4*)(x2 + 1024 * j + 16 * lane + 4 * q);
            out[j * 8 + 2 * q] += (f32x2){a.x, a.y}; out[j * 8 + 2 * q + 1] += (f32x2){a.z, a.w};
            ss += out[j * 8 + 2 * q].x * out[j * 8 + 2 * q].x + out[j * 8 + 2 * q].y * out[j * 8 + 2 * q].y + out[j * 8 + 2 * q + 1].x * out[j * 8 + 2 * q + 1].x + out[j * 8 + 2 * q + 1].y * out[j * 8 + 2 * q + 1].y; }
    const float rn = rsqrtf(wave_sum(ss) * (1.f / DM) + EPS);
    float* yo = A.out + (t < TPR ? O_YP + (size_t)t * DM : O_YS + (size_t)(t - TPR) * DM); const float* gn = A.in[I_NF];
#pragma unroll
    for (int j = 0; j < 2; ++j)
#pragma unroll
        for (int q = 0; q < 4; ++q) { const f32x4 g = *(const f32x4*)(gn + 1024 * j + 16 * lane + 4 * q);
            *(f32x4*)(yo + 1024 * j + 16 * lane + 4 * q) = (f32x4){out[j * 8 + 2 * q].x * rn * g.x, out[j * 8 + 2 * q].y * rn * g.y, out[j * 8 + 2 * q + 1].x * rn * g.z, out[j * 8 + 2 * q + 1].y * rn * g.w}; }
}

constexpr int NPHASE = 14;
__global__ void __launch_bounds__(NTHR, 2) hymba_fwd(Args args) {
    extern __shared__ __attribute__((aligned(16))) unsigned char lds[];
    Frame F;
    F.lds = (LAS unsigned char*)lds;
    F.tid = threadIdx.x; F.lane = F.tid & 63; F.wave = __builtin_amdgcn_readfirstlane(F.tid >> 6);
    F.G = gridDim.x; { const int bx = blockIdx.x; F.vcu = (F.G % 8 == 0) ? (bx % 8) * (F.G / 8) + bx / 8 : bx; }
    volatile LAS unsigned* MISC = (volatile LAS unsigned*)(F.lds + MISC_OFF);
    if (F.tid < 64) MISC[F.tid] = 0u;
    __syncthreads();
    unsigned char* ws = args.ws;
    XcdBarrier bar; bar.bar = (unsigned*)(ws + WS_CTL) + CW_BAR; bar.x = 0; bar.st = nullptr;
    const int lo = args.ph_lo, hi = args.ph_hi;
    if (hi - lo > 1) bar = xcd_barrier_post((unsigned*)(ws + WS_CTL) + CW_BAR, MISC + 8);
#ifndef PHASE_MASK
#define PHASE_MASK 0xFFFF
#endif
#define IN(k) (((PHASE_MASK >> (k)) & 1) && lo <= (k) && (k) < hi)
#define SEAM(k) do { if (IN(k) && IN((k) + 1)) xcd_barrier(bar); } while (0)
#ifndef PROBE_DUP
#define PROBE_DUP -1
#endif
#define REPS(k) for (int rep_ = 0; rep_ < ((PROBE_DUP == (k)) ? 2 : 1); ++rep_, ((PROBE_DUP == (k)) && rep_ < 2 ? xcd_barrier(bar) : (void)0))
    const int gw = F.vcu * NWAVES + F.wave, NGW = F.G * NWAVES;

    if (IN(0)) REPS(0) { phase_prologue(F, args); } SEAM(0);

    if (IN(1)) REPS(1) {
        { pg8::Gemm g{(const bf16*)(ws + WS_XN), (const bf16*)(ws + WS_WIN), NTOK, NIN, DM}; pg8::StaticOrder S; S.init(NTOK, NIN, F.G, (int)blockIdx.x);
          pg8::EpiBf16 E{(bf16*)(ws + WS_H), NIN};
          pg8::gemm_phase<pg8::EpiBf16, pg8::StaticOrder, true, true>(F.lds, g, S, E); }
        { pg8::Gemm g{(const bf16*)(ws + WS_MN), (const bf16*)(ws + WS_WKV), 1024, 4096, DM}; pg8::StaticOrder S; S.init(1024, 4096, F.G, (int)((blockIdx.x + F.G - 84 % F.G) % F.G));
          pg8::EpiKV E{args.out + O_PMK, args.out + O_PMV, (bf16*)(ws + WS_KP), (bf16*)(ws + WS_VPT)};
          pg8::gemm_phase<pg8::EpiKV, pg8::StaticOrder, true, true>(F.lds, g, S, E); }
    } SEAM(1);

    if (IN(2)) REPS(2) {
        for (int it = F.vcu; it < 256 + 512; it += F.G) { if (it < 256) ssd_pass1_item(F, args, it); else ssd_sample_item(F, args, it - 256); }
        short_conv_all(F, args);
    } SEAM(2);

    if (IN(3)) REPS(3) { ssd_propagate(F, args); } SEAM(3);

    if (IN(4)) REPS(4) { for (int it = F.vcu; it < 256; it += F.G) ssd_pass2_item(F, args, it); } SEAM(4);

    if (IN(5)) REPS(5) {
        pg8::Gemm g{(const bf16*)(ws + WS_YM), (const bf16*)(ws + WS_WOUT), NTOK, DM, 4096}; pg8::StaticOrder S; S.init(NTOK, DM, F.G, (int)blockIdx.x);
        pg8::EpiRes<true> E{(float*)(ws + WS_X1), args.in[I_XP], args.in[I_XS]};
        pg8::gemm_phase<pg8::EpiRes<true>, pg8::StaticOrder, true, true>(F.lds, g, S, E);
    } SEAM(5);

    if (IN(6)) REPS(6) { phase_norm_rows(F, args, args.in[I_NMQ]); } SEAM(6);

    if (IN(7)) REPS(7) {
        pg8::Gemm g{(const bf16*)(ws + WS_XN), (const bf16*)(ws + WS_WQ), NTOK, DM, DM}; pg8::StaticOrder S; S.init(NTOK, DM, F.G, (int)blockIdx.x);
        pg8::EpiBf16 E{(bf16*)(ws + WS_QB), DM};
        pg8::gemm_phase<pg8::EpiBf16, pg8::StaticOrder, true, true>(F.lds, g, S, E);
    } SEAM(7);

    if (IN(8)) REPS(8) { for (int it = F.vcu; it < 256 + 512; it += F.G) { if (it < 256) attn_prompt_unit(F, args, it); else attn_sample_unit(F, args, it - 256); } } SEAM(8);

    if (IN(9)) REPS(9) {
        pg8::Gemm g{(const bf16*)(ws + WS_OB), (const bf16*)(ws + WS_WO), NTOK, DM, DM}; pg8::StaticOrder S; S.init(NTOK, DM, F.G, (int)blockIdx.x);
        pg8::EpiRes<false> E{(float*)(ws + WS_X1), nullptr, nullptr};
        pg8::gemm_phase<pg8::EpiRes<false>, pg8::StaticOrder, true, true>(F.lds, g, S, E);
    } SEAM(9);

    if (IN(10)) REPS(10) { phase_norm_rows(F, args, args.in[I_NFFN]); } SEAM(10);

    if (IN(11)) REPS(11) {
        pg8::Gemm g{(const bf16*)(ws + WS_XN), (const bf16*)(ws + WS_WPQ), NTOK, DM, DM}; pg8::StaticOrder S; S.init(NTOK, DM, F.G, (int)blockIdx.x);
        pg8::EpiBf16 E{(bf16*)(ws + WS_QB), DM};
        pg8::gemm_phase<pg8::EpiBf16, pg8::StaticOrder, true, true>(F.lds, g, S, E);
    } SEAM(11);

    if (IN(12)) REPS(12) { for (int u = gw; u < (NTOK / 16) * 8; u += NGW) peer_topk_unit(args, u, F.lane); } SEAM(12);

    if (IN(13)) REPS(13) {
        unsigned* qhead = (unsigned*)(ws + WS_CTL) + CW_PEERQ + 64 * (PROBE_DUP == 13 ? rep_ : 0);
        for (int t = gw; t < NTOK;) { peer_gather_token(args, t, F.lane);
            unsigned nx = 0; if (F.lane == 0) nx = __hip_atomic_fetch_add(qhead, 1u, __ATOMIC_RELAXED, __HIP_MEMORY_SCOPE_AGENT); t = NGW + (int)__builtin_amdgcn_readfirstlane(nx); } }
#undef IN
#undef SEAM
}

extern "C" void kernel_launch(void* const* d_in, const int* in_sizes, int n_in, void* d_out, int out_size, void* d_ws, size_t ws_size, hipStream_t stream) {
    static int grid = 0;
    if (grid == 0) {
        if (n_in != 30 || out_size != (int)O_END || ws_size < WS_END) { fprintf(stderr, "kernel_launch: unexpected shapes: n_in %d out %d ws %zu (need %zu)\n", n_in, out_size, ws_size, (size_t)WS_END); grid = -1; return; }
        int dev = 0, cus = 0, per_cu = 0;
        if (hipGetDevice(&dev) != hipSuccess || hipDeviceGetAttribute(&cus, hipDeviceAttributeMultiprocessorCount, dev) != hipSuccess) { grid = -1; return; }
        if (hipFuncSetAttribute((const void*)hymba_fwd, hipFuncAttributeMaxDynamicSharedMemorySize, LDS_BYTES) != hipSuccess) { fprintf(stderr, "kernel_launch: hipFuncSetAttribute failed\n"); grid = -1; return; }
        if (hipOccupancyMaxActiveBlocksPerMultiprocessor(&per_cu, (const void*)hymba_fwd, NTHR, LDS_BYTES) != hipSuccess || per_cu < 1) { fprintf(stderr, "kernel_launch: occupancy query says %d\n", per_cu); }
        (void)hipGetLastError();
        grid = cus;
    }
    if (grid < 0) return;
    hipMemsetAsync((char*)d_ws + WS_CTL, 0, CTL_ZERO_BYTES, stream);
    Args a{};
    for (int i = 0; i < 30; ++i) a.in[i] = (const float*)d_in[i];
    a.out = (float*)d_out; a.ws = (unsigned char*)d_ws;
#if MK_ONE_LAUNCH
    a.ph_lo = 0; a.ph_hi = NPHASE;
    hipLaunchKernelGGL(hymba_fwd, dim3(grid), dim3(NTHR), LDS_BYTES, stream, a);
#else
    for (int p = 0; p < NPHASE; ++p) { a.ph_lo = p; a.ph_hi = p + 1; hipLaunchKernelGGL(hymba_fwd, dim3(grid), dim3(NTHR), LDS_BYTES, stream, a); }
#endif
}
```
